# Optimizing an MI355X kernel written in HIP

```python
import jax, jax.numpy as jnp
from jax import lax
import numpy as np

D_MODEL = 2048
BATCH = 2
SEQ = 16384
DEPTH = 1

CHUNK = 64
QUERY_BLOCK = 128
SB_HEADS = 8
SB_HEAD_DIM = 128
MLA_HEADS = 8
MLA_NOPE_DIM = 128
MLA_ROPE_DIM = 64
MLA_V_DIM = 128
MLA_Q_RANK = 768
MLA_KV_RANK = 512
N_BRANCHES = 2
D_FF = -(-8 * D_MODEL // (3 * 256)) * 256
ROPE_THETA = 10000.0
NORM_EPS = 1e-6
NEG_INF = -1e30

SB_WIDTH = SB_HEADS * SB_HEAD_DIM
MLA_QK_DIM = MLA_NOPE_DIM + MLA_ROPE_DIM
IN_WIDTHS = [SB_WIDTH, SB_WIDTH, SB_WIDTH, MLA_Q_RANK, MLA_KV_RANK, MLA_ROPE_DIM, N_BRANCHES * D_MODEL]
D_IN = int(sum(IN_WIDTHS))
IN_OFFSETS = [int(o) for o in np.cumsum(IN_WIDTHS)[:-1]]

kernel_name = "sandwich_gated_stickbreaking_mla_swiglu"


def rms_norm(x, g):
    xf = x.astype(jnp.float32)
    y = xf * lax.rsqrt(jnp.mean(xf * xf, axis=-1, keepdims=True) + NORM_EPS)
    return (y * g.astype(jnp.float32)).astype(x.dtype)


def rope(x, positions):
    half = MLA_ROPE_DIM // 2
    inv_freq = ROPE_THETA ** (-jnp.arange(half, dtype=jnp.float32) / half)
    ang = positions.astype(jnp.float32)[..., None] * inv_freq
    if x.ndim == 4:
        ang = ang[:, :, None, :]
    cos, sin = jnp.cos(ang), jnp.sin(ang)
    xf = x.astype(jnp.float32)
    x1, x2 = xf[..., :half], xf[..., half:]
    return jnp.concatenate([x1 * cos - x2 * sin, x2 * cos + x1 * sin], axis=-1).astype(x.dtype)


def to_blocks(t):
    b, s = t.shape[:2]
    return jnp.moveaxis(t.reshape(b, s // QUERY_BLOCK, QUERY_BLOCK, *t.shape[2:]), 1, 0)


def from_blocks(t):
    t = jnp.moveaxis(t, 0, 1)
    return t.reshape(t.shape[0], -1, *t.shape[3:])


def stick_breaking_attention(q, k, v):
    seq = k.shape[1]
    scale = SB_HEAD_DIM ** -0.5
    key_pos = jnp.arange(seq)

    def one_block(args):
        qb, blk = args
        z = jnp.einsum('bqhd,bkhd->bhqk', qb, k).astype(jnp.float32) * scale
        q_pos = blk * QUERY_BLOCK + jnp.arange(QUERY_BLOCK)
        valid = key_pos[None, :] < q_pos[:, None]
        log_keep = jnp.where(valid, jax.nn.log_sigmoid(-z), 0.0)
        log_suffix = lax.cumsum(log_keep, axis=3, reverse=True) - log_keep
        w = jnp.where(valid, jnp.exp(jax.nn.log_sigmoid(z) + log_suffix), 0.0)
        return jnp.einsum('bhqk,bkhd->bqhd', w.astype(v.dtype), v)

    n_blocks = q.shape[1] // QUERY_BLOCK
    return from_blocks(lax.map(one_block, (to_blocks(q), jnp.arange(n_blocks))))


def mla_attention(q_nope, q_rope, k_nope, k_rope, v):
    seq = k_nope.shape[1]
    scale = MLA_QK_DIM ** -0.5
    key_chunk = jnp.arange(seq) // CHUNK

    def one_block(args):
        qn, qr, blk = args
        s = (jnp.einsum('bqhd,bkhd->bhqk', qn, k_nope)
             + jnp.einsum('bqhr,bkr->bhqk', qr, k_rope)).astype(jnp.float32) * scale
        q_chunk = (blk * QUERY_BLOCK + jnp.arange(QUERY_BLOCK)) // CHUNK
        allowed = key_chunk[None, :] <= q_chunk[:, None]
        p = jax.nn.softmax(jnp.where(allowed, s, NEG_INF), axis=-1)
        return jnp.einsum('bhqk,bkhd->bqhd', p.astype(v.dtype), v)

    n_blocks = q_nope.shape[1] // QUERY_BLOCK
    out = lax.map(one_block, (to_blocks(q_nope), to_blocks(q_rope), jnp.arange(n_blocks)))
    return from_blocks(out)


def setup_inputs(seed: int = 0) -> dict:
    key = jax.random.key(seed)
    ks = jax.random.split(key, 20)
    f32 = jnp.float32

    def w(k, shape, fan_in):
        return jax.random.normal(k, shape, f32) * fan_in ** -0.5

    def gain(k, dim):
        return 1.0 + 0.1 * jax.random.normal(k, (DEPTH, dim), f32)

    x = jax.random.normal(ks[0], (BATCH, SEQ, D_MODEL), f32)
    offsets = jax.random.randint(ks[1], (BATCH, 1), 0, 4096) * CHUNK
    positions = (offsets + jnp.arange(SEQ, dtype=jnp.int32)[None, :]).astype(jnp.int32)
    return {
        "x": x,
        "positions": positions,
        "norm_pre_mix": gain(ks[2], D_MODEL),
        "w_in": w(ks[3], (DEPTH, D_MODEL, D_IN), D_MODEL),
        "b_gate": 0.1 * jax.random.normal(ks[4], (DEPTH, N_BRANCHES * D_MODEL), f32),
        "q_norm": gain(ks[5], MLA_Q_RANK),
        "w_uq": w(ks[6], (DEPTH, MLA_Q_RANK, MLA_HEADS * MLA_QK_DIM), MLA_Q_RANK),
        "kv_norm": gain(ks[7], MLA_KV_RANK),
        "w_ukv": w(ks[8], (DEPTH, MLA_KV_RANK, MLA_HEADS * (MLA_NOPE_DIM + MLA_V_DIM)), MLA_KV_RANK),
        "w_o_sb": w(ks[9], (DEPTH, SB_WIDTH, D_MODEL), SB_WIDTH),
        "w_o_mla": w(ks[10], (DEPTH, MLA_HEADS * MLA_V_DIM, D_MODEL), MLA_HEADS * MLA_V_DIM),
        "w_out": w(ks[11], (DEPTH, D_MODEL, D_MODEL), D_MODEL),
        "norm_post_mix": gain(ks[12], D_MODEL),
        "norm_pre_ffn": gain(ks[13], D_MODEL),
        "w_gate_up": w(ks[14], (DEPTH, D_MODEL, 2 * D_FF), D_MODEL),
        "w_down": w(ks[15], (DEPTH, D_FF, D_MODEL), D_FF),
        "norm_post_ffn": gain(ks[16], D_MODEL),
    }


def reference(x, positions, norm_pre_mix, w_in, b_gate, q_norm, w_uq, kv_norm, w_ukv,
              w_o_sb, w_o_mla, w_out, norm_post_mix, norm_pre_ffn, w_gate_up, w_down,
              norm_post_ffn):
    b, s, _ = x.shape
    h = x
    for l in range(DEPTH):
        u = rms_norm(h, norm_pre_mix[l])
        proj = u @ w_in[l]
        q_sb, k_sb, v_sb, q_lat, kv_lat, k_r, gate_logits = jnp.split(proj, IN_OFFSETS, axis=-1)

        q_sb = q_sb.reshape(b, s, SB_HEADS, SB_HEAD_DIM)
        k_sb = k_sb.reshape(b, s, SB_HEADS, SB_HEAD_DIM)
        v_sb = v_sb.reshape(b, s, SB_HEADS, SB_HEAD_DIM)
        y_sb = stick_breaking_attention(q_sb, k_sb, v_sb).reshape(b, s, SB_WIDTH) @ w_o_sb[l]

        q = (rms_norm(q_lat, q_norm[l]) @ w_uq[l]).reshape(b, s, MLA_HEADS, MLA_QK_DIM)
        q_nope, q_rope = q[..., :MLA_NOPE_DIM], rope(q[..., MLA_NOPE_DIM:], positions)
        kv = (rms_norm(kv_lat, kv_norm[l]) @ w_ukv[l]).reshape(b, s, MLA_HEADS, MLA_NOPE_DIM + MLA_V_DIM)
        k_nope, v_mla = kv[..., :MLA_NOPE_DIM], kv[..., MLA_NOPE_DIM:]
        k_rope = rope(k_r, positions)
        y_mla = mla_attention(q_nope, q_rope, k_nope, k_rope, v_mla).reshape(b, s, MLA_HEADS * MLA_V_DIM) @ w_o_mla[l]

        gates = jax.nn.sigmoid((gate_logits + b_gate[l]).astype(jnp.float32)).astype(h.dtype)
        g_sb, g_mla = gates[..., :D_MODEL], gates[..., D_MODEL:]
        mixed = (g_sb * y_sb + g_mla * y_mla) @ w_out[l]
        h = h + rms_norm(mixed, norm_post_mix[l])

        gu = rms_norm(h, norm_pre_ffn[l]) @ w_gate_up[l]
        g, up = gu[..., :D_FF], gu[..., D_FF:]
        h = h + rms_norm((jax.nn.silu(g) * up) @ w_down[l], norm_post_ffn[l])
    return h
```

```cpp
#include <hip/hip_runtime.h>
#include <cstdio>
#include <cstdint>
#include <cmath>
namespace pg8 {
#define PG8_LAS __attribute__((address_space(3)))
typedef unsigned short bf16_t;
typedef short bf16x8 __attribute__((ext_vector_type(8)));
typedef float f32x4 __attribute__((ext_vector_type(4)));
typedef unsigned u32x4 __attribute__((ext_vector_type(4)));
constexpr int BM = 256, BK = 64, HALF = 128, HTB = HALF * BK * 2  , STAGE_BYTES = 8 * HTB, NXCD = 8, WGM = 8;

__host__ __device__ __forceinline__ int lds_byte(int r, int c) { const int st = (r >> 4) * 2 + (c >> 5), rr = r & 15, cc = c & 31, ob = rr * 64 + cc * 2; return st * 1024 + (ob ^ (((ob >> 9) & 1) << 5)); }
__host__ __device__ __forceinline__ void stage_rc(int b, int& R, int& C) { const int st = b / 1024, sb = b % 1024, swz = sb ^ (((sb >> 9) & 1) << 5); R = (st >> 1) * 16 + swz / 64; C = (st & 1) * 32 + (swz % 64) / 2; }
__host__ __device__ __forceinline__ int perm32(int rho) { const int n = rho >> 4, i = rho & 15; return 8 * (i >> 2) + 4 * n + (i & 3); }

struct Unit { int pm, pn; };
struct Gemm { const bf16_t* A; const bf16_t* Bt; int M, N, K; };

struct StaticOrder {
    int nM, nN, nwg, G, c;
    __host__ __device__ void init(int M, int N, int G_, int c_) { nM = M / BM; nN = N / BM; nwg = nM * nN; G = G_; c = c_; }
    __host__ __device__ bool next(int i, Unit& u) const {
        const long L = (long)i * G + c; if (L >= nwg) return false;
        int wgid = (int)L; { const int q = nwg / NXCD, r = nwg % NXCD, xcd = wgid % NXCD, off = wgid / NXCD; wgid = (xcd < r ? xcd * (q + 1) : r * (q + 1) + (xcd - r) * q) + off; }
        const int nig = WGM * nN, gid = wgid / nig, fm = gid * WGM, gsz = (nM - fm) < WGM ? (nM - fm) : WGM;
        u.pm = fm + ((wgid % nig) % gsz); u.pn = (wgid % nig) / gsz; return true;
    }
    __device__ __forceinline__ void a_ready(const Unit&) const {}
    __device__ __forceinline__ void done(const Unit&) const {}
};

__device__ __forceinline__ unsigned cvt_pk_bf16(float lo, float hi) { typedef float f2_ __attribute__((ext_vector_type(2))); typedef __bf16 b2_ __attribute__((ext_vector_type(2))); f2_ v = {lo, hi}; b2_ b = __builtin_convertvector(v, b2_); return __builtin_bit_cast(unsigned, b); }
typedef float f32x2 __attribute__((ext_vector_type(2)));
__device__ __forceinline__ f32x2 gelu_pk(f32x2 v) {
    const f32x2 av = __builtin_elementwise_abs(v), d = av * 0.2316418882f + 1.0f;
    f32x2 t; t.x = __builtin_amdgcn_rcpf(d.x); t.y = __builtin_amdgcn_rcpf(d.y);
    f32x2 q = t * 0.5307027145f + (-0.7265760135f); q = q * t + 0.7107068705f; q = q * t + (-0.142248368f); q = q * t + 0.127414796f; q = q * t;
    const f32x2 s = (v * v) * (-0.72134752044f);
    f32x2 e; e.x = __builtin_amdgcn_exp2f(s.x); e.y = __builtin_amdgcn_exp2f(s.y);
    const f32x2 m = v * (q * e), r = v - m;
    f32x2 o; o.x = v.x < 0.f ? m.x : r.x; o.y = v.y < 0.f ? m.y : r.y; return o;
}

template <class Epi, class Sched, bool ALIGN_EPI = false, bool SP2 = false>
__device__ __forceinline__ void gemm_phase(PG8_LAS unsigned char* lds, const Gemm g, const Sched& S, const Epi& E) {
    const int tid = threadIdx.x, wid = __builtin_amdgcn_readfirstlane(tid >> 6), lane = tid & 63, wr = wid >> 2, wc = wid & 3, fr = lane & 15, fq = lane >> 4;
    const int K = g.K, nt = K / BK;
    unsigned voffA[2], voffB[2];
#pragma unroll
    for (int i = 0; i < 2; ++i) { int R, C; stage_rc(tid * 16 + i * 8192, R, C); const int Rb = Epi::PERM ? ((R & ~31) + perm32(R & 31)) : R;
        voffA[i] = (unsigned)(R * K + C) * 2u; voffB[i] = (unsigned)(Rb * K + C) * 2u; }
    const size_t kstep = (size_t)(BK * 2);
    const size_t hstep = (size_t)HALF * K * 2;
    const size_t tstep = 2 * hstep;
    const unsigned ldsw = (unsigned)wid * 1024u;
    const int aoff = lds_byte(wr * 64 + fr, fq * 8), boff = lds_byte(wc * 32 + fr, fq * 8);
#define PG8_SA(b, h) (((b) * 2 + (h)) * HTB)
#define PG8_SB(b, h) ((4 + (b) * 2 + (h)) * HTB)
#define PG8_STAGE(bufoff, gbase, voff) do { _Pragma("unroll") for (int _i = 0; _i < 2; ++_i) \
        __builtin_amdgcn_global_load_lds((const unsigned*)((const char*)(gbase) + (voff)[_i]), (PG8_LAS unsigned*)(lds + (bufoff) + ldsw + _i * 8192), 16, 0, 0); } while (0)
#define PG8_LDA(dst, b, h) do { _Pragma("unroll") for (int m = 0; m < 4; ++m) _Pragma("unroll") for (int k = 0; k < 2; ++k) dst[m][k] = *(const PG8_LAS bf16x8*)(lds + PG8_SA(b, h) + aoff + m * 2048 + k * 1024); } while (0)
#define PG8_LDB(dst, b, h) do { _Pragma("unroll") for (int n = 0; n < 2; ++n) _Pragma("unroll") for (int k = 0; k < 2; ++k) dst[n][k] = *(const PG8_LAS bf16x8*)(lds + PG8_SB(b, h) + boff + n * 2048 + k * 1024); } while (0)
#define PG8_MMA(ai, bj, At, Bt) do { __builtin_amdgcn_s_setprio(1); _Pragma("unroll") for (int m = 0; m < 4; ++m) _Pragma("unroll") for (int n = 0; n < 2; ++n) _Pragma("unroll") for (int k = 0; k < 2; ++k) \
        acc[ai][bj][m][n] = __builtin_amdgcn_mfma_f32_16x16x32_bf16(Bt[n][k], At[m][k], acc[ai][bj][m][n], 0, 0, 0); __builtin_amdgcn_s_setprio(0); } while (0)
#define PG8_WAIT_V(n) asm volatile("s_waitcnt vmcnt(" #n ")" ::: "memory")
#define PG8_WAIT_L(n) asm volatile("s_waitcnt lgkmcnt(" #n ")" ::: "memory")
#define PG8_BAR __builtin_amdgcn_s_barrier()
#define PG8_SCHED __builtin_amdgcn_sched_barrier(0)
    Unit cur, nxt; int ui = 0;
    if (!S.next(0, cur)) return;
    f32x4 acc[2][2][4][2];
#pragma unroll
    for (int a = 0; a < 2; ++a)
#pragma unroll
        for (int b = 0; b < 2; ++b)
#pragma unroll
            for (int m = 0; m < 4; ++m)
#pragma unroll
                for (int n = 0; n < 2; ++n) acc[a][b][m][n] = (f32x4){0.f, 0.f, 0.f, 0.f};
    bf16x8 At[4][2], B0[2][2], B1[2][2];
    const char* cA = (const char*)g.A + (size_t)cur.pm * tstep; const char* cB = (const char*)g.Bt + (size_t)cur.pn * tstep;
    S.a_ready(cur);
    if constexpr (SP2) {
        PG8_STAGE(PG8_SB(0, 0), cB, voffB); PG8_STAGE(PG8_SB(0, 1), cB + hstep, voffB); PG8_STAGE(PG8_SA(0, 0), cA, voffA); PG8_STAGE(PG8_SA(0, 1), cA + hstep, voffA);
        if (wr == 1) PG8_BAR;
        PG8_WAIT_V(2); PG8_BAR;
        PG8_STAGE(PG8_SB(1, 0), cB + kstep, voffB); PG8_STAGE(PG8_SA(1, 0), cA + kstep, voffA); PG8_STAGE(PG8_SB(1, 1), cB + hstep + kstep, voffB);
        PG8_WAIT_V(6); PG8_BAR;
    } else {
        PG8_STAGE(PG8_SB(0, 0), cB, voffB); PG8_STAGE(PG8_SA(0, 0), cA, voffA); PG8_STAGE(PG8_SB(0, 1), cB + hstep, voffB); PG8_STAGE(PG8_SA(0, 1), cA + hstep, voffA);
        if (wr == 1) PG8_BAR;
        PG8_WAIT_V(4); PG8_BAR;
        PG8_STAGE(PG8_SB(1, 0), cB + kstep, voffB); PG8_STAGE(PG8_SA(1, 0), cA + kstep, voffA); PG8_STAGE(PG8_SB(1, 1), cB + hstep + kstep, voffB);
        PG8_WAIT_V(6); PG8_BAR;
    }
    for (;;) {
        const bool has_next = S.next(ui + 1, nxt);
        const char* nA = has_next ? (const char*)g.A + (size_t)nxt.pm * tstep : cA; const char* nB = has_next ? (const char*)g.Bt + (size_t)nxt.pn * tstep : cB;
        for (int t = 0; t < nt; t += 2) {
            const bool last = (t == nt - 2);
            const char* a1 = cA + (size_t)(t + 1) * kstep;
            const char* a2 = last ? nA : cA + (size_t)(t + 2) * kstep; const char* b2 = last ? nB : cB + (size_t)(t + 2) * kstep;
            const char* a3 = a2 + kstep; const char* b3 = b2 + kstep;
            if (last && has_next) S.a_ready(nxt);
            if constexpr (SP2) {
            PG8_LDB(B0, 0, 0); PG8_LDB(B1, 0, 1); PG8_SCHED; PG8_LDA(At, 0, 0); PG8_STAGE(PG8_SA(1, 1), a1 + hstep, voffA);
            PG8_WAIT_V(8); PG8_WAIT_L(0); PG8_BAR; PG8_MMA(0, 0, At, B0); PG8_MMA(0, 1, At, B1); PG8_BAR; PG8_SCHED;
            PG8_LDA(At, 0, 1); PG8_STAGE(PG8_SB(0, 0), b2, voffB); PG8_STAGE(PG8_SB(0, 1), b2 + hstep, voffB); PG8_STAGE(PG8_SA(0, 0), a2, voffA);
            PG8_WAIT_V(8); PG8_WAIT_L(0); PG8_BAR; PG8_MMA(1, 0, At, B0); PG8_MMA(1, 1, At, B1); PG8_BAR; PG8_SCHED;
            PG8_LDB(B0, 1, 0); PG8_LDB(B1, 1, 1); PG8_SCHED; PG8_LDA(At, 1, 0); PG8_STAGE(PG8_SA(0, 1), a2 + hstep, voffA);
            PG8_WAIT_V(8); PG8_WAIT_L(0); PG8_BAR; PG8_MMA(0, 0, At, B0); PG8_MMA(0, 1, At, B1); PG8_BAR; PG8_SCHED;
            PG8_LDA(At, 1, 1); PG8_STAGE(PG8_SB(1, 0), b3, voffB); PG8_STAGE(PG8_SB(1, 1), b3 + hstep, voffB); PG8_STAGE(PG8_SA(1, 0), a3, voffA);
            PG8_WAIT_V(8); PG8_WAIT_L(0); PG8_BAR; PG8_MMA(1, 0, At, B0); PG8_MMA(1, 1, At, B1); PG8_BAR; PG8_SCHED;
            } else {
            PG8_LDB(B0, 0, 0); PG8_SCHED; PG8_LDA(At, 0, 0); PG8_STAGE(PG8_SA(1, 1), a1 + hstep, voffA);
            PG8_WAIT_L(8); PG8_BAR; PG8_WAIT_L(0); PG8_MMA(0, 0, At, B0); PG8_BAR; PG8_SCHED;
            PG8_LDB(B1, 0, 1); PG8_STAGE(PG8_SB(0, 0), b2, voffB);
            PG8_BAR; PG8_WAIT_L(0); PG8_MMA(0, 1, At, B1); PG8_BAR;
            PG8_LDA(At, 0, 1); PG8_STAGE(PG8_SA(0, 0), a2, voffA);
            PG8_BAR; PG8_WAIT_L(0); PG8_MMA(1, 0, At, B0); PG8_BAR; PG8_SCHED;
            PG8_STAGE(PG8_SB(0, 1), b2 + hstep, voffB);
            PG8_WAIT_V(6); PG8_BAR; PG8_MMA(1, 1, At, B1); PG8_BAR;
            PG8_LDB(B0, 1, 0); PG8_SCHED; PG8_LDA(At, 1, 0); PG8_STAGE(PG8_SA(0, 1), a2 + hstep, voffA);
            PG8_WAIT_L(8); PG8_BAR; PG8_WAIT_L(0); PG8_MMA(0, 0, At, B0); PG8_BAR; PG8_SCHED;
            PG8_LDB(B1, 1, 1); PG8_STAGE(PG8_SB(1, 0), b3, voffB);
            PG8_BAR; PG8_WAIT_L(0); PG8_MMA(0, 1, At, B1); PG8_BAR;
            PG8_LDA(At, 1, 1); PG8_STAGE(PG8_SA(1, 0), a3, voffA);
            PG8_BAR; PG8_WAIT_L(0); PG8_MMA(1, 0, At, B0); PG8_BAR; PG8_SCHED;
            PG8_STAGE(PG8_SB(1, 1), b3 + hstep, voffB);
            PG8_WAIT_V(6); PG8_BAR; PG8_MMA(1, 1, At, B1); PG8_BAR;
            }
        }
        if constexpr (ALIGN_EPI) { if (wr == 0) PG8_BAR; }
        if constexpr (!Epi::AFTER_DRAIN) { E(acc, cur, wr, wc, fr, fq); S.done(cur); }
        if (!has_next) break;
#pragma unroll
        for (int a = 0; a < 2; ++a)
#pragma unroll
            for (int b = 0; b < 2; ++b)
#pragma unroll
                for (int m = 0; m < 4; ++m)
#pragma unroll
                    for (int n = 0; n < 2; ++n) acc[a][b][m][n] = (f32x4){0.f, 0.f, 0.f, 0.f};
        cur = nxt; cA = nA; cB = nB; ++ui;
        if constexpr (ALIGN_EPI) { if (wr == 1) PG8_BAR; }
    }
    PG8_WAIT_V(0);
    if constexpr (!ALIGN_EPI) { if (wr == 0) PG8_BAR; }
    PG8_BAR;
    if constexpr (Epi::AFTER_DRAIN) { E.fused(acc, cur, wr, wc, fr, fq, lds, wid, lane); S.done(cur); }
#undef PG8_SA
#undef PG8_SB
#undef PG8_STAGE
#undef PG8_LDA
#undef PG8_LDB
#undef PG8_MMA
#undef PG8_WAIT_V
#undef PG8_WAIT_L
#undef PG8_BAR
#undef PG8_SCHED
}
}
#define LAS __attribute__((address_space(3)))
typedef pg8::bf16_t bf16_t;
typedef short bf16x8 __attribute__((ext_vector_type(8)));
typedef short s16x4 __attribute__((ext_vector_type(4)));
typedef float f32x4 __attribute__((ext_vector_type(4)));
typedef float f32x16 __attribute__((ext_vector_type(16)));
typedef unsigned u32x4 __attribute__((ext_vector_type(4)));
typedef unsigned u32x2 __attribute__((ext_vector_type(2)));

constexpr int BATCH = 2, SEQ = 16384, T = BATCH * SEQ, DM = 2048, DFF = 5632;
constexpr int N1 = 8704;
constexpr float EPS = 1e-6f;
constexpr float LOG2E = 1.4426950408889634f, LN2 = 0.6931471805599453f;
constexpr float SB_SCALE = 0.08838834764831845f;
constexpr float MLA_C2 = 0.07216878364870323f * LOG2E;
constexpr float SB_EXIT = -110.0f;

constexpr size_t MiB = 1u << 20;
constexpr size_t W_IN = 1 * MiB;
constexpr size_t W_UQ = W_IN + (size_t)N1 * 2048 * 2;
constexpr size_t W_UKV = W_UQ + (size_t)1536 * 768 * 2;
constexpr size_t W_OSB = W_UKV + (size_t)2048 * 512 * 2;
constexpr size_t W_OMLA = W_OSB + (size_t)2048 * 1024 * 2;
constexpr size_t W_OUT = W_OMLA + (size_t)2048 * 1024 * 2;
constexpr size_t W_GU = W_OUT + (size_t)2048 * 2048 * 2;
constexpr size_t W_DN = W_GU + (size_t)11264 * 2048 * 2;
constexpr size_t W_END = W_DN + (size_t)2048 * 5632 * 2;
static_assert(W_END <= 122 * MiB, "weights region");
constexpr size_t A_U = 122 * MiB;
constexpr size_t A_QSB = 250 * MiB;
constexpr size_t A_KSB = 314 * MiB;
constexpr size_t A_VSB = 378 * MiB;
constexpr size_t A_TMP = A_KSB;
constexpr size_t A_QLAT = 442 * MiB;
constexpr size_t A_KVLAT = 490 * MiB;
constexpr size_t A_MLAO = A_QLAT;
constexpr size_t A_KR = 522 * MiB;
constexpr size_t A_KROPE = 530 * MiB;
constexpr size_t A_CS = 534 * MiB;
constexpr size_t A_Q = 542 * MiB;
constexpr size_t A_KN = 638 * MiB;
constexpr size_t A_VM = 702 * MiB;
constexpr size_t A_MIXED = A_Q;
constexpr size_t A_ACT = 250 * MiB;
constexpr size_t A_SBO = A_U;
constexpr size_t A_GATES = 766 * MiB;
constexpr size_t WS_NEED = 1022 * MiB;
static_assert(A_KSB - A_QSB == (size_t)T * 2048 && A_VSB - A_KSB == (size_t)T * 2048 && A_VM - A_KN == (size_t)T * 2048, "contiguous q/k/v");
static_assert(A_ACT + (size_t)T * DFF * 2 <= WS_NEED && A_VM + (size_t)T * 1024 * 2 <= WS_NEED, "ws map");

constexpr int LDS_BYTES = 147456;

__device__ __forceinline__ unsigned f2bf(float f) { unsigned u = __builtin_bit_cast(unsigned, f); return (u + 0x7fffu + ((u >> 16) & 1u)) >> 16; }
__device__ __forceinline__ unsigned pk2(float lo, float hi) { return f2bf(lo) | (f2bf(hi) << 16); }
__device__ __forceinline__ float bflo(unsigned w) { return __builtin_bit_cast(float, w << 16); }
__device__ __forceinline__ float bfhi(unsigned w) { return __builtin_bit_cast(float, w & 0xffff0000u); }
__device__ __forceinline__ float ex2(float x) { return __builtin_amdgcn_exp2f(x); }
__device__ __forceinline__ float sigmoidf_(float x) { return __builtin_amdgcn_rcpf(1.0f + ex2(-x * LOG2E)); }
__device__ __forceinline__ int lane_id() { int l; asm volatile("v_mbcnt_lo_u32_b32 %0, -1, 0\n\tv_mbcnt_hi_u32_b32 %0, -1, %0" : "=v"(l)); return l; }
__device__ __forceinline__ float wave_sum(float v) {
#pragma unroll
    for (int o = 1; o < 64; o <<= 1) v += __shfl_xor(v, o);
    return v;
}

namespace pg8 {
typedef const f32x4 (&AccRef)[2][2][4][2];
__device__ __forceinline__ void store_tile_bf16(AccRef acc, bf16_t* base, int ld, int rowb, int c0, float sc) {
#pragma unroll
    for (int ai = 0; ai < 2; ++ai)
#pragma unroll
        for (int m = 0; m < 4; ++m) { bf16_t* rowp = base + (size_t)(rowb + ai * HALF + m * 16) * ld + c0;
#pragma unroll
            for (int bj = 0; bj < 2; ++bj) { const f32x4 v0 = acc[ai][bj][m][0] * sc, v1 = acc[ai][bj][m][1] * sc; u32x4 w;
                w.x = cvt_pk_bf16(v0[0], v0[1]); w.y = cvt_pk_bf16(v0[2], v0[3]); w.z = cvt_pk_bf16(v1[0], v1[1]); w.w = cvt_pk_bf16(v1[2], v1[3]);
                *(u32x4*)(rowp + bj * HALF) = w; } }
}
struct Epi1 {
    static constexpr bool PERM = true, AFTER_DRAIN = false;
    bf16_t *qkv  , *qlat, *kvlat, *gates; float* kr; const float* bgate;
    __device__ __forceinline__ void operator()(AccRef acc, const Unit& u, int wr, int wc, int fr, int fq) const {
        const int pn = u.pn, rowb = u.pm * BM + wr * 64 + fr, cw = wc * 32 + 8 * fq;
        if (pn < 12) { bf16_t* base = qkv + (size_t)(pn >> 2) * ((size_t)T * 1024); store_tile_bf16(acc, base, 1024, rowb, (pn & 3) * 256 + cw, pn < 4 ? SB_SCALE : 1.0f); }
        else if (pn < 15) store_tile_bf16(acc, qlat, 768, rowb, (pn - 12) * 256 + cw, 1.0f);
        else if (pn < 17) store_tile_bf16(acc, kvlat, 512, rowb, (pn - 15) * 256 + cw, 1.0f);
        else if (pn < 33) {
            const int c0 = (pn - 17) * 256 + cw;
            f32x4 bv[2][2];
#pragma unroll
            for (int bj = 0; bj < 2; ++bj)
#pragma unroll
                for (int n = 0; n < 2; ++n) bv[bj][n] = *(const f32x4*)(bgate + c0 + bj * HALF + 4 * n);
#pragma unroll
            for (int ai = 0; ai < 2; ++ai)
#pragma unroll
                for (int m = 0; m < 4; ++m) { bf16_t* rowp = gates + (size_t)(rowb + ai * HALF + m * 16) * 4096 + c0;
#pragma unroll
                    for (int bj = 0; bj < 2; ++bj) { const f32x4 v0 = acc[ai][bj][m][0] + bv[bj][0], v1 = acc[ai][bj][m][1] + bv[bj][1]; u32x4 w;
                        w.x = cvt_pk_bf16(sigmoidf_(v0[0]), sigmoidf_(v0[1])); w.y = cvt_pk_bf16(sigmoidf_(v0[2]), sigmoidf_(v0[3]));
                        w.z = cvt_pk_bf16(sigmoidf_(v1[0]), sigmoidf_(v1[1])); w.w = cvt_pk_bf16(sigmoidf_(v1[2]), sigmoidf_(v1[3]));
                        *(u32x4*)(rowp + bj * HALF) = w; } }
        } else if (wc < 2) {
#pragma unroll
            for (int ai = 0; ai < 2; ++ai)
#pragma unroll
                for (int m = 0; m < 4; ++m) { float* rowp = kr + (size_t)(rowb + ai * HALF + m * 16) * 64 + cw;
                    *(f32x4*)rowp = acc[ai][0][m][0]; *(f32x4*)(rowp + 4) = acc[ai][0][m][1]; }
        }
    }
};
struct EpiQ {
    static constexpr bool PERM = true, AFTER_DRAIN = false;
    bf16_t* q; const float* cs;
    __device__ __forceinline__ void operator()(AccRef acc, const Unit& u, int wr, int wc, int fr, int fq) const {
        const int pn = u.pn, rowb = u.pm * BM + wr * 64 + fr, cw = wc * 32 + 8 * fq;
        if (pn < 4) {
#pragma unroll
            for (int ai = 0; ai < 2; ++ai)
#pragma unroll
                for (int m = 0; m < 4; ++m) { bf16_t* rowp = q + (size_t)(rowb + ai * HALF + m * 16) * 1536 + cw;
#pragma unroll
                    for (int bj = 0; bj < 2; ++bj) { const f32x4 v0 = acc[ai][bj][m][0] * MLA_C2, v1 = acc[ai][bj][m][1] * MLA_C2; u32x4 w;
                        w.x = cvt_pk_bf16(v0[0], v0[1]); w.y = cvt_pk_bf16(v0[2], v0[3]); w.z = cvt_pk_bf16(v1[0], v1[1]); w.w = cvt_pk_bf16(v1[2], v1[3]);
                        *(u32x4*)(rowp + (2 * pn + bj) * 192) = w; } }
        } else {
            const int head = (pn - 4) * 4 + wc, i0 = 8 * fq;
#pragma unroll
            for (int ai = 0; ai < 2; ++ai)
#pragma unroll
                for (int m = 0; m < 4; ++m) { const int row = rowb + ai * HALF + m * 16; const float* cp = cs + (size_t)row * 64 + i0;
                    const f32x4 c0 = *(const f32x4*)cp, c1 = *(const f32x4*)(cp + 4), s0 = *(const f32x4*)(cp + 32), s1 = *(const f32x4*)(cp + 36);
                    const f32x4 a0 = acc[ai][0][m][0], a1 = acc[ai][0][m][1], b0 = acc[ai][1][m][0], b1 = acc[ai][1][m][1];
                    const f32x4 o10 = (a0 * c0 - b0 * s0) * MLA_C2, o11 = (a1 * c1 - b1 * s1) * MLA_C2, o20 = (b0 * c0 + a0 * s0) * MLA_C2, o21 = (b1 * c1 + a1 * s1) * MLA_C2;
                    bf16_t* rowp = q + (size_t)row * 1536 + head * 192 + 128 + i0; u32x4 w;
                    w.x = cvt_pk_bf16(o10[0], o10[1]); w.y = cvt_pk_bf16(o10[2], o10[3]); w.z = cvt_pk_bf16(o11[0], o11[1]); w.w = cvt_pk_bf16(o11[2], o11[3]);
                    *(u32x4*)rowp = w;
                    w.x = cvt_pk_bf16(o20[0], o20[1]); w.y = cvt_pk_bf16(o20[2], o20[3]); w.z = cvt_pk_bf16(o21[0], o21[1]); w.w = cvt_pk_bf16(o21[2], o21[3]);
                    *(u32x4*)(rowp + 32) = w; }
        }
    }
};
struct EpiKV {
    static constexpr bool PERM = true, AFTER_DRAIN = false;
    bf16_t* kv;
    __device__ __forceinline__ void operator()(AccRef acc, const Unit& u, int wr, int wc, int fr, int fq) const {
        const int pn = u.pn; store_tile_bf16(acc, kv + (size_t)(pn >> 2) * ((size_t)T * 1024), 1024, u.pm * BM + wr * 64 + fr, (pn & 3) * 256 + wc * 32 + 8 * fq, 1.0f);
    }
};
struct EpiPlain {
    static constexpr bool PERM = true, AFTER_DRAIN = false;
    bf16_t* o; int ld;
    __device__ __forceinline__ void operator()(AccRef acc, const Unit& u, int wr, int wc, int fr, int fq) const {
        store_tile_bf16(acc, o, ld, u.pm * BM + wr * 64 + fr, u.pn * 256 + wc * 32 + 8 * fq, 1.0f);
    }
};
template <bool SECOND> struct EpiGate {
    static constexpr bool PERM = true, AFTER_DRAIN = false;
    const bf16_t* gates; bf16_t* tmp; bf16_t* out;
    __device__ __forceinline__ void operator()(AccRef acc, const Unit& u, int wr, int wc, int fr, int fq) const {
        const int rowb = u.pm * BM + wr * 64 + fr, c0 = u.pn * 256 + wc * 32 + 8 * fq;
#pragma unroll
        for (int ai = 0; ai < 2; ++ai)
#pragma unroll
            for (int m = 0; m < 4; ++m) { const size_t row = (size_t)(rowb + ai * HALF + m * 16);
#pragma unroll
                for (int bj = 0; bj < 2; ++bj) { const int c = c0 + bj * HALF;
                    const u32x4 g = *(const u32x4*)(gates + row * 4096 + (SECOND ? 2048 : 0) + c);
                    const f32x4 a0 = acc[ai][bj][m][0], a1 = acc[ai][bj][m][1];
                    float r[8] = {a0[0] * bflo(g.x), a0[1] * bfhi(g.x), a0[2] * bflo(g.y), a0[3] * bfhi(g.y), a1[0] * bflo(g.z), a1[1] * bfhi(g.z), a1[2] * bflo(g.w), a1[3] * bfhi(g.w)};
                    if (SECOND) { const u32x4 t = *(const u32x4*)(tmp + row * 2048 + c);
                        r[0] += bflo(t.x); r[1] += bfhi(t.x); r[2] += bflo(t.y); r[3] += bfhi(t.y); r[4] += bflo(t.z); r[5] += bfhi(t.z); r[6] += bflo(t.w); r[7] += bfhi(t.w); }
                    u32x4 w; w.x = cvt_pk_bf16(r[0], r[1]); w.y = cvt_pk_bf16(r[2], r[3]); w.z = cvt_pk_bf16(r[4], r[5]); w.w = cvt_pk_bf16(r[6], r[7]);
                    *(u32x4*)((SECOND ? out : tmp) + row * 2048 + c) = w; } }
    }
};
struct EpiSwiglu {
    static constexpr bool PERM = true, AFTER_DRAIN = false;
    bf16_t* act;
    __device__ __forceinline__ void operator()(AccRef acc, const Unit& u, int wr, int wc, int fr, int fq) const {
        const int rowb = u.pm * BM + wr * 64 + fr, c0 = u.pn * 128 + wc * 32 + 8 * fq;
#pragma unroll
        for (int ai = 0; ai < 2; ++ai)
#pragma unroll
            for (int m = 0; m < 4; ++m) { const f32x4 g0 = acc[ai][0][m][0], g1 = acc[ai][0][m][1], u0 = acc[ai][1][m][0], u1 = acc[ai][1][m][1]; float r[8];
#pragma unroll
                for (int k = 0; k < 4; ++k) { r[k] = g0[k] * sigmoidf_(g0[k]) * u0[k]; r[4 + k] = g1[k] * sigmoidf_(g1[k]) * u1[k]; }
                u32x4 w; w.x = cvt_pk_bf16(r[0], r[1]); w.y = cvt_pk_bf16(r[2], r[3]); w.z = cvt_pk_bf16(r[4], r[5]); w.w = cvt_pk_bf16(r[6], r[7]);
                *(u32x4*)(act + (size_t)(rowb + ai * HALF + m * 16) * DFF + c0) = w; }
    }
};
}

namespace att {
constexpr int VSTR = 320, VOFF = 64 * 400, STAGE = VOFF + 64 * VSTR  , FLAG_OFF = 2 * STAGE;
typedef short v4i16_t __attribute__((ext_vector_type(4)));
__device__ __forceinline__ int crow(int r, int hi) { return (r & 3) + 8 * (r >> 2) + 4 * hi; }
__device__ __forceinline__ unsigned cvtpk(float lo, float hi) { typedef float f2 __attribute__((ext_vector_type(2))); typedef __bf16 b2 __attribute__((ext_vector_type(2))); f2 v = {lo, hi}; b2 b = __builtin_convertvector(v, b2); return __builtin_bit_cast(unsigned, b); }
__device__ __forceinline__ s16x4 vtr(const LAS unsigned char* p) { return __builtin_bit_cast(s16x4, __builtin_amdgcn_ds_read_tr16_b64_v4i16((LAS v4i16_t*)p)); }
__device__ __forceinline__ float partner(float x, int hi) { auto rr = __builtin_amdgcn_permlane32_swap(__float_as_uint(x), __float_as_uint(x), false, false); return __uint_as_float(hi ? rr[0] : rr[1]); }

#ifndef EXP_SKIP_SB
#define EXP_SKIP_SB 0
#endif
template <bool MLA>
__device__ __forceinline__ void attn_unit(LAS unsigned char* lds, const int b, const int h, const int qb,
        const bf16_t* Q, const bf16_t* __restrict__ K, const bf16_t* __restrict__ KR, const bf16_t* __restrict__ V, bf16_t* O) {
    constexpr int DK = MLA ? 192 : 128, NKS = DK / 16, KSTR = DK * 2 + 16, QP = MLA ? 1536 : 1024;
    const int tid = threadIdx.x, lane = tid & 63, r32 = lane & 31, hi = lane >> 5;
    const int wid = __builtin_amdgcn_readfirstlane(tid >> 6);
    const size_t rowbase = (size_t)b * SEQ;
    const int q0 = qb * 256, NT = 4 * qb + 4, tdiag = 4 * qb + (wid >> 1);
    if (!MLA && EXP_SKIP_SB) { bf16_t* orow_ = O + (rowbase + q0 + wid * 32 + r32) * 1024 + h * 128 + 4 * hi;
        for (int dt = 0; dt < 4; ++dt) for (int g = 0; g < 4; ++g) { u32x2 w; w.x = 0x3f803f00u + (unsigned)((r32 + dt + g) & 7) * 0x00010001u; w.y = 0xbf803e80u; *(u32x2*)(orow_ + dt * 32 + 8 * g) = w; }
        return; }
    const int srow = tid >> 4, sch = tid & 15;
    const bf16_t* kg = K + (rowbase + srow) * 1024 + h * 128 + sch * 8;
    const bf16_t* vg = V + (rowbase + srow) * 1024 + h * 128 + sch * 8;
    const bf16_t* rg = KR + (rowbase + (tid >> 3)) * 64 + (tid & 7) * 8;
    const int kdst = srow * KSTR + sch * 16, vdst = VOFF + srow * VSTR + sch * 16, rdst = (tid >> 3) * KSTR + 256 + (tid & 7) * 16;
    u32x4 sk0, sk1, sv0, sv1, sr;
#define ATT_LOAD(tt) do { const size_t o_ = (size_t)(tt) * 65536; sk0 = *(const u32x4*)(kg + o_); sk1 = *(const u32x4*)(kg + o_ + 32768); sv0 = *(const u32x4*)(vg + o_); sv1 = *(const u32x4*)(vg + o_ + 32768); \
        if (MLA) sr = *(const u32x4*)(rg + (size_t)(tt) * 4096); } while (0)
#define ATT_STORE(so) do { *(LAS u32x4*)(lds + (so) + kdst) = sk0; *(LAS u32x4*)(lds + (so) + kdst + 32 * KSTR) = sk1; *(LAS u32x4*)(lds + (so) + vdst) = sv0; *(LAS u32x4*)(lds + (so) + vdst + 32 * VSTR) = sv1; \
        if (MLA) *(LAS u32x4*)(lds + (so) + rdst) = sr; } while (0)
    const int t0 = MLA ? 0 : NT - 1, tstep = MLA ? 1 : -1;
    ATT_LOAD(t0);
    bf16x8 qf[NKS];
    { const bf16_t* qrow = Q + (rowbase + q0 + wid * 32 + r32) * QP + h * DK + hi * 8;
#pragma unroll
      for (int d0 = 0; d0 < NKS; ++d0) qf[d0] = *(const bf16x8*)(qrow + d0 * 16); }
    f32x16 o[4];
#pragma unroll
    for (int i = 0; i < 4; ++i)
#pragma unroll
        for (int r = 0; r < 16; ++r) o[i][r] = 0.f;
    float m_ref = -INFINITY, lsum = 0.f, R = 0.f;
    const int kfb = r32 * KSTR + hi * 16;
    const int vfb = VOFF + (4 * hi + ((lane & 15) >> 2)) * VSTR + (((lane >> 4) & 1) * 16 + (lane & 3) * 4) * 2;
    volatile LAS unsigned* flags = (volatile LAS unsigned*)(lds + FLAG_OFF);
    ATT_STORE(0);
    __syncthreads();
    int t = t0;
    for (int it = 0; it < NT; ++it, t += tstep) {
        const int st = (it & 1) * STAGE;
        const bool more = it + 1 < NT;
        if (more) ATT_LOAD(t + tstep);
        if (t <= tdiag) {
            f32x16 p0, p1;
#pragma unroll
            for (int r = 0; r < 16; ++r) { p0[r] = 0.f; p1[r] = 0.f; }
#pragma unroll
            for (int d0 = 0; d0 < NKS; ++d0) {
                const bf16x8 k0 = *(const LAS bf16x8*)(lds + st + kfb + d0 * 32);
                const bf16x8 k1 = *(const LAS bf16x8*)(lds + st + kfb + 32 * KSTR + d0 * 32);
                p0 = __builtin_amdgcn_mfma_f32_32x32x16_bf16(k0, qf[d0], p0, 0, 0, 0);
                p1 = __builtin_amdgcn_mfma_f32_32x32x16_bf16(k1, qf[d0], p1, 0, 0, 0);
            }
            if (MLA) {
                float tm = fmaxf(p0[0], p1[0]);
#pragma unroll
                for (int r = 1; r < 16; ++r) tm = fmaxf(tm, fmaxf(p0[r], p1[r]));
                tm = fmaxf(tm, partner(tm, hi));
                if (__any(tm > m_ref + 8.0f)) {
                    const float mn = fmaxf(m_ref, tm), sc = ex2(m_ref - mn);
                    lsum *= sc;
#pragma unroll
                    for (int i = 0; i < 4; ++i)
#pragma unroll
                        for (int r = 0; r < 16; ++r) o[i][r] *= sc;
                    m_ref = mn;
                }
                float ps = 0.f;
#pragma unroll
                for (int r = 0; r < 16; ++r) { p0[r] = ex2(p0[r] - m_ref); p1[r] = ex2(p1[r] - m_ref); ps += p0[r] + p1[r]; }
                lsum += ps;
            } else {
                const bool diag = (t == tdiag);
                const int qrel = (wid & 1) * 32 + r32;
                float lk[32];
#pragma unroll
                for (int x = 0; x < 32; ++x) {
                    const float z = x < 16 ? p0[x] : p1[x - 16];
                    const int kv = (x < 16 ? 0 : 32) + crow(x & 15, hi);
                    const bool valid = !diag || kv < qrel;
                    const float e = ex2(-fabsf(z) * LOG2E);
                    const float sp = fmaxf(z, 0.f) + LN2 * __builtin_amdgcn_logf(1.0f + e);
                    lk[x] = valid ? -sp : 0.f;
                }
                float gs[8], ot[8], ST[8];
#pragma unroll
                for (int k = 0; k < 8; ++k) { gs[k] = (lk[4 * k] + lk[4 * k + 1]) + (lk[4 * k + 2] + lk[4 * k + 3]); ot[k] = partner(gs[k], hi); }
                ST[7] = 0.f;
#pragma unroll
                for (int k = 6; k >= 0; --k) ST[k] = ST[k + 1] + (gs[k + 1] + ot[k + 1]);
                const float tot = ST[0] + (gs[0] + ot[0]);
#pragma unroll
                for (int k = 0; k < 8; ++k) {
                    const float s3 = R + ST[k] + (hi == 0 ? ot[k] : 0.f);
                    const float s2 = s3 + lk[4 * k + 3], s1 = s2 + lk[4 * k + 2], s0 = s1 + lk[4 * k + 1];
                    const float ss[4] = {s0, s1, s2, s3};
#pragma unroll
                    for (int i = 0; i < 4; ++i) {
                        const int x = 4 * k + i;
                        const float z = x < 16 ? p0[x] : p1[x - 16];
                        const int kv = (x < 16 ? 0 : 32) + crow(x & 15, hi);
                        const bool valid = !diag || kv < qrel;
                        const float w = valid ? ex2((z + lk[x] + ss[i]) * LOG2E) : 0.f;
                        if (x < 16) p0[x] = w; else p1[x - 16] = w;
                    }
                }
                R += tot;
            }
            bf16x8 pf[4];
            { u32x4 w;
              w.x = cvtpk(p0[0], p0[1]); w.y = cvtpk(p0[2], p0[3]); w.z = cvtpk(p0[4], p0[5]); w.w = cvtpk(p0[6], p0[7]); pf[0] = __builtin_bit_cast(bf16x8, w);
              w.x = cvtpk(p0[8], p0[9]); w.y = cvtpk(p0[10], p0[11]); w.z = cvtpk(p0[12], p0[13]); w.w = cvtpk(p0[14], p0[15]); pf[1] = __builtin_bit_cast(bf16x8, w);
              w.x = cvtpk(p1[0], p1[1]); w.y = cvtpk(p1[2], p1[3]); w.z = cvtpk(p1[4], p1[5]); w.w = cvtpk(p1[6], p1[7]); pf[2] = __builtin_bit_cast(bf16x8, w);
              w.x = cvtpk(p1[8], p1[9]); w.y = cvtpk(p1[10], p1[11]); w.z = cvtpk(p1[12], p1[13]); w.w = cvtpk(p1[14], p1[15]); pf[3] = __builtin_bit_cast(bf16x8, w); }
#pragma unroll
            for (int s = 0; s < 4; ++s)
#pragma unroll
                for (int dt = 0; dt < 4; ++dt) {
                    const s16x4 lo = vtr(lds + st + vfb + s * 16 * VSTR + dt * 64);
                    const s16x4 hh = vtr(lds + st + vfb + s * 16 * VSTR + dt * 64 + 8 * VSTR);
                    const bf16x8 vf = {lo[0], lo[1], lo[2], lo[3], hh[0], hh[1], hh[2], hh[3]};
                    o[dt] = __builtin_amdgcn_mfma_f32_32x32x16_bf16(vf, pf[s], o[dt], 0, 0, 0);
                }
        }
        if (!MLA) { const bool dn = __all(R <= SB_EXIT); if (lane == 0) flags[(it & 1) * 8 + wid] = dn ? 1u : 0u; }
        if (more) ATT_STORE(((it + 1) & 1) * STAGE);
        __syncthreads();
        if (!MLA) { unsigned a = 1u;
#pragma unroll
            for (int w = 0; w < 8; ++w) a &= flags[(it & 1) * 8 + w];
#ifndef EXP_NO_EXIT
            if (a) break;
#else
            if (a == 12345u) break;
#endif
            }
    }
#undef ATT_LOAD
#undef ATT_STORE
    float inv = 1.0f;
    if (MLA) inv = __builtin_amdgcn_rcpf(lsum + partner(lsum, hi));
    bf16_t* orow = O + (rowbase + q0 + wid * 32 + r32) * 1024 + h * 128 + 4 * hi;
#pragma unroll
    for (int dt = 0; dt < 4; ++dt)
#pragma unroll
        for (int g = 0; g < 4; ++g) { u32x2 w; w.x = cvtpk(o[dt][4 * g] * inv, o[dt][4 * g + 1] * inv); w.y = cvtpk(o[dt][4 * g + 2] * inv, o[dt][4 * g + 3] * inv);
            *(u32x2*)(orow + dt * 32 + 8 * g) = w; }
}
}

#include <hip/hip_cooperative_groups.h>
namespace cg = cooperative_groups;
#ifndef MK_COOP
#define MK_COOP 1
#endif
constexpr int NPH = 12;
struct Args { const float* in[17]; float* out; unsigned char* ws; float invf[32]; int ph_lo, ph_hi; };
static_assert(sizeof(Args) == 17 * 8 + 16 + 128 + 8, "Args has no padding");

__device__ __forceinline__ void transpose_item(const float* __restrict__ W, int K, int N, bf16_t* __restrict__ WT, int k0, int n0, int drow, LAS float* scr, int lane) {
#pragma unroll 8
    for (int i = 0; i < 32; ++i) { const int kk = 2 * i + (lane >> 5); scr[kk * 33 + (lane & 31)] = W[(size_t)(k0 + kk) * N + n0 + (lane & 31)]; }
    asm volatile("s_waitcnt lgkmcnt(0)" ::: "memory");
    const int c = lane & 7;
#pragma unroll
    for (int j = 0; j < 4; ++j) { const int n = (lane >> 3) + 8 * j; const LAS float* s = scr + (8 * c) * 33 + n;
        u32x4 o; o.x = pk2(s[0 * 33], s[1 * 33]); o.y = pk2(s[2 * 33], s[3 * 33]); o.z = pk2(s[4 * 33], s[5 * 33]); o.w = pk2(s[6 * 33], s[7 * 33]);
        *(u32x4*)(WT + (size_t)(drow + n) * K + k0 + 8 * c) = o; }
    asm volatile("s_waitcnt lgkmcnt(0)" ::: "memory");
}
__device__ __forceinline__ int dst_row(int id, int n0) {
    switch (id) {
    case 0: return n0 < 4352 ? n0 : (n0 < 4416 ? 8448 + (n0 - 4352) : 4352 + (n0 - 4416));
    case 1: { const int h = n0 / 192, j = n0 % 192; return j < 128 ? h * 128 + j : 1024 + (h >> 2) * 256 + (j >= 160 ? 128 : 0) + (h & 3) * 32; }
    case 2: { const int h = n0 >> 8, j = n0 & 255; return j < 128 ? h * 128 + j : 1024 + h * 128 + (j - 128); }
    case 6: { const int up = n0 >= DFF, j = up ? n0 - DFF : n0; return (j >> 7) * 256 + (up ? 128 : 0) + (j & 127); }
    default: return n0;
    }
}

__global__ void __launch_bounds__(512) mk_fwd(Args args) {
    __builtin_assume(__builtin_amdgcn_workitem_id_y() == 0); __builtin_assume(__builtin_amdgcn_workitem_id_z() == 0);
    extern __shared__ __attribute__((aligned(16))) unsigned char lds_raw[];
    LAS unsigned char* lds = (LAS unsigned char*)lds_raw;
    cg::grid_group grid = cg::this_grid();
    const int wave = __builtin_amdgcn_readfirstlane(threadIdx.x >> 6);
    const int G = gridDim.x, bx = blockIdx.x;
    const int vcu = (G % 8 == 0) ? (bx % 8) * (G / 8) + bx / 8 : bx;
    const int gw = vcu * 8 + wave, NGW = G * 8;
    unsigned char* ws = args.ws;
    const int lo = args.ph_lo, hi_ = args.ph_hi;
#define IN(k) (lo <= (k) && (k) < hi_)
#define SEAM(k) do { if (IN(k) && IN((k) + 1)) grid.sync(); } while (0)
    bf16_t* U = (bf16_t*)(ws + A_U);
    bf16_t* gates = (bf16_t*)(ws + A_GATES);
    float* h1 = (float*)(ws + A_GATES);

    if (IN(0)) {
        const int lane = lane_id();
        LAS float* scr = (LAS float*)(lds + wave * 16384);
        int base = 0;
#define CONV(id, Wp, Kk, Nn, Off) do { const int nblk = (Nn) / 32, items = ((Kk) / 64) * nblk; \
            for (int it = gw - base; it < items; it += NGW) { if (it < 0) continue; \
                const int kb = it / nblk, nb = it % nblk; transpose_item((Wp), (Kk), (Nn), (bf16_t*)(ws + (Off)), 64 * kb, 32 * nb, dst_row((id), 32 * nb), scr, lane); } \
            base = (base + items) % NGW; } while (0)
        CONV(0, args.in[3], 2048, 8512, W_IN); CONV(1, args.in[6], 768, 1536, W_UQ); CONV(2, args.in[8], 512, 2048, W_UKV); CONV(3, args.in[9], 1024, 2048, W_OSB);
        CONV(4, args.in[10], 1024, 2048, W_OMLA); CONV(5, args.in[11], 2048, 2048, W_OUT); CONV(6, args.in[14], 2048, 2 * DFF, W_GU); CONV(7, args.in[15], DFF, 2048, W_DN);
#undef CONV
        const float* g = args.in[2];
        for (int m = gw; m < T; m += NGW) {
            const f32x4* xr = (const f32x4*)(args.in[0] + (size_t)m * DM) + lane; f32x4 v[8]; float s = 0.f;
#pragma unroll
            for (int j = 0; j < 8; ++j) { v[j] = xr[64 * j]; s += (v[j].x * v[j].x + v[j].y * v[j].y) + (v[j].z * v[j].z + v[j].w * v[j].w); }
            const float rstd = 1.0f / sqrtf(wave_sum(s) * (1.0f / DM) + EPS);
            u32x2* o8 = (u32x2*)(U + (size_t)m * DM) + lane;
#pragma unroll
            for (int j = 0; j < 8; ++j) { const f32x4 gg = *((const f32x4*)g + lane + 64 * j); u32x2 w; w.x = pk2(v[j].x * rstd * gg.x, v[j].y * rstd * gg.y); w.y = pk2(v[j].z * rstd * gg.z, v[j].w * rstd * gg.w); o8[64 * j] = w; }
        }
    }
    SEAM(0);
    if (IN(1)) {
        pg8::Gemm g{U, (const bf16_t*)(ws + W_IN), T, N1, 2048}; pg8::StaticOrder S; S.init(T, N1, G, bx);
        pg8::Epi1 E{(bf16_t*)(ws + A_QSB), (bf16_t*)(ws + A_QLAT), (bf16_t*)(ws + A_KVLAT), gates, (float*)(ws + A_KR), args.in[4]};
        pg8::gemm_phase<pg8::Epi1, pg8::StaticOrder, true, true>(lds, g, S, E);
    }
    SEAM(1);
    if (IN(2)) {
        const int lane = lane_id();
        const float* gq = args.in[5]; const float* gkv = args.in[7]; const int* pos = (const int*)args.in[1];
        for (int m = gw; m < T; m += NGW) {
            { u32x2* p = (u32x2*)(ws + A_QLAT + (size_t)m * 768 * 2) + lane; u32x2 w[3]; float s = 0.f;
#pragma unroll
              for (int j = 0; j < 3; ++j) { w[j] = p[64 * j]; const float a = bflo(w[j].x), b = bfhi(w[j].x), c = bflo(w[j].y), d = bfhi(w[j].y); s += (a * a + b * b) + (c * c + d * d); }
              const float rstd = 1.0f / sqrtf(wave_sum(s) * (1.0f / 768.0f) + EPS);
#pragma unroll
              for (int j = 0; j < 3; ++j) { const f32x4 gg = *((const f32x4*)gq + lane + 64 * j); u32x2 o; o.x = pk2(bflo(w[j].x) * rstd * gg.x, bfhi(w[j].x) * rstd * gg.y); o.y = pk2(bflo(w[j].y) * rstd * gg.z, bfhi(w[j].y) * rstd * gg.w); p[64 * j] = o; } }
            { u32x2* p = (u32x2*)(ws + A_KVLAT + (size_t)m * 512 * 2) + lane; u32x2 w[2]; float s = 0.f;
#pragma unroll
              for (int j = 0; j < 2; ++j) { w[j] = p[64 * j]; const float a = bflo(w[j].x), b = bfhi(w[j].x), c = bflo(w[j].y), d = bfhi(w[j].y); s += (a * a + b * b) + (c * c + d * d); }
              const float rstd = 1.0f / sqrtf(wave_sum(s) * (1.0f / 512.0f) + EPS);
#pragma unroll
              for (int j = 0; j < 2; ++j) { const f32x4 gg = *((const f32x4*)gkv + lane + 64 * j); u32x2 o; o.x = pk2(bflo(w[j].x) * rstd * gg.x, bfhi(w[j].x) * rstd * gg.y); o.y = pk2(bflo(w[j].y) * rstd * gg.z, bfhi(w[j].y) * rstd * gg.w); p[64 * j] = o; } }
            { const int i = lane & 31; const float ang = (float)pos[m] * args.invf[i];
              double rev = (double)ang * 0.15915494309189535; rev -= floor(rev); const float rf = (float)rev;
              const float sn = __builtin_amdgcn_sinf(rf), cn = __builtin_amdgcn_cosf(rf);
              const float* kr = (const float*)(ws + A_KR) + (size_t)m * 64; const float x1 = kr[i], x2 = kr[i + 32];
              float* cs = (float*)(ws + A_CS) + (size_t)m * 64; bf16_t* ko = (bf16_t*)(ws + A_KROPE) + (size_t)m * 64;
              if (lane < 32) { cs[i] = cn; ko[i] = (bf16_t)f2bf(x1 * cn - x2 * sn); } else { cs[32 + i] = sn; ko[32 + i] = (bf16_t)f2bf(x2 * cn + x1 * sn); } }
        }
    }
    SEAM(2);
    if (IN(3)) {
        { pg8::Gemm g{(const bf16_t*)(ws + A_QLAT), (const bf16_t*)(ws + W_UQ), T, 1536, 768}; pg8::StaticOrder S; S.init(T, 1536, G, bx);
          pg8::EpiQ E{(bf16_t*)(ws + A_Q), (const float*)(ws + A_CS)}; pg8::gemm_phase<pg8::EpiQ, pg8::StaticOrder, true, true>(lds, g, S, E); }
        { pg8::Gemm g{(const bf16_t*)(ws + A_KVLAT), (const bf16_t*)(ws + W_UKV), T, 2048, 512}; pg8::StaticOrder S; S.init(T, 2048, G, bx);
          pg8::EpiKV E{(bf16_t*)(ws + A_KN)}; pg8::gemm_phase<pg8::EpiKV, pg8::StaticOrder, true, true>(lds, g, S, E); }
    }
    SEAM(3);
    if (IN(4)) {
        const int nvc = (G % 16 == 0) ? G / 16 : 0;
        if (nvc) {
            const int bh = vcu / nvc, s = vcu % nvc, npb = 64 / nvc;
            for (int i = npb - 1; i >= 0; --i) { const int pr = (i >> 1) * nvc + s, qb = (i & 1) ? 63 - pr : pr;
                att::attn_unit<true>(lds, bh >> 3, bh & 7, qb, (const bf16_t*)(ws + A_Q), (const bf16_t*)(ws + A_KN), (const bf16_t*)(ws + A_KROPE), (const bf16_t*)(ws + A_VM), (bf16_t*)(ws + A_MLAO)); }
            for (int i = 0; i < npb; ++i) { const int qb = i * nvc + s;
                att::attn_unit<false>(lds, bh >> 3, bh & 7, qb, (const bf16_t*)(ws + A_QSB), (const bf16_t*)(ws + A_KSB), nullptr, (const bf16_t*)(ws + A_VSB), (bf16_t*)(ws + A_SBO)); }
        } else {
            for (int u = bx; u < 1024; u += G) { const int bh = u >> 6, qb = 63 - (u & 63);
                att::attn_unit<true>(lds, bh >> 3, bh & 7, qb, (const bf16_t*)(ws + A_Q), (const bf16_t*)(ws + A_KN), (const bf16_t*)(ws + A_KROPE), (const bf16_t*)(ws + A_VM), (bf16_t*)(ws + A_MLAO));
                att::attn_unit<false>(lds, bh >> 3, bh & 7, qb, (const bf16_t*)(ws + A_QSB), (const bf16_t*)(ws + A_KSB), nullptr, (const bf16_t*)(ws + A_VSB), (bf16_t*)(ws + A_SBO)); }
        }
    }
    SEAM(4);
    if (IN(5)) {
        { pg8::Gemm g{(const bf16_t*)(ws + A_SBO), (const bf16_t*)(ws + W_OSB), T, 2048, 1024}; pg8::StaticOrder S; S.init(T, 2048, G, bx);
          pg8::EpiGate<false> E{gates, (bf16_t*)(ws + A_TMP), U}; pg8::gemm_phase<pg8::EpiGate<false>, pg8::StaticOrder, true, true>(lds, g, S, E); }
    }
    SEAM(5);
    if (IN(6)) {
        { pg8::Gemm g{(const bf16_t*)(ws + A_MLAO), (const bf16_t*)(ws + W_OMLA), T, 2048, 1024}; pg8::StaticOrder S; S.init(T, 2048, G, bx);
          pg8::EpiGate<true> E{gates, (bf16_t*)(ws + A_TMP), U}; pg8::gemm_phase<pg8::EpiGate<true>, pg8::StaticOrder, true, true>(lds, g, S, E); }
    }
    SEAM(6);
    if (IN(7)) {
        pg8::Gemm g{U, (const bf16_t*)(ws + W_OUT), T, 2048, 2048}; pg8::StaticOrder S; S.init(T, 2048, G, bx);
        pg8::EpiPlain E{(bf16_t*)(ws + A_MIXED), 2048}; pg8::gemm_phase<pg8::EpiPlain, pg8::StaticOrder, true, true>(lds, g, S, E);
    }
    SEAM(7);
    if (IN(8)) {
        const int lane = lane_id();
        const float* g1 = args.in[12]; const float* g2 = args.in[13];
        for (int m = gw; m < T; m += NGW) {
            const u32x4* mp = (const u32x4*)(ws + A_MIXED + (size_t)m * DM * 2) + lane; const f32x4* xr = (const f32x4*)(args.in[0] + (size_t)m * DM);
            float v[32]; float s = 0.f;
#pragma unroll
            for (int j = 0; j < 4; ++j) { const u32x4 w = mp[64 * j]; v[8 * j] = bflo(w.x); v[8 * j + 1] = bfhi(w.x); v[8 * j + 2] = bflo(w.y); v[8 * j + 3] = bfhi(w.y); v[8 * j + 4] = bflo(w.z); v[8 * j + 5] = bfhi(w.z); v[8 * j + 6] = bflo(w.w); v[8 * j + 7] = bfhi(w.w); }
#pragma unroll
            for (int e = 0; e < 32; ++e) s += v[e] * v[e];
            const float rstd = 1.0f / sqrtf(wave_sum(s) * (1.0f / DM) + EPS); float s2 = 0.f;
#pragma unroll
            for (int j = 0; j < 4; ++j)
#pragma unroll
                for (int q = 0; q < 2; ++q) { const int c4 = (lane + 64 * j) * 2 + q; const f32x4 xx = xr[c4], gg = ((const f32x4*)g1)[c4]; f32x4 hh;
                    hh.x = xx.x + v[8 * j + 4 * q] * rstd * gg.x; hh.y = xx.y + v[8 * j + 4 * q + 1] * rstd * gg.y; hh.z = xx.z + v[8 * j + 4 * q + 2] * rstd * gg.z; hh.w = xx.w + v[8 * j + 4 * q + 3] * rstd * gg.w;
                    ((f32x4*)(h1 + (size_t)m * DM))[c4] = hh; v[8 * j + 4 * q] = hh.x; v[8 * j + 4 * q + 1] = hh.y; v[8 * j + 4 * q + 2] = hh.z; v[8 * j + 4 * q + 3] = hh.w;
                    s2 += (hh.x * hh.x + hh.y * hh.y) + (hh.z * hh.z + hh.w * hh.w); }
            const float rstd2 = 1.0f / sqrtf(wave_sum(s2) * (1.0f / DM) + EPS);
            u32x4* up = (u32x4*)(U + (size_t)m * DM) + lane;
#pragma unroll
            for (int j = 0; j < 4; ++j) { const int c4 = (lane + 64 * j) * 2; const f32x4 ga = ((const f32x4*)g2)[c4], gb = ((const f32x4*)g2)[c4 + 1]; u32x4 w;
                w.x = pk2(v[8 * j] * rstd2 * ga.x, v[8 * j + 1] * rstd2 * ga.y); w.y = pk2(v[8 * j + 2] * rstd2 * ga.z, v[8 * j + 3] * rstd2 * ga.w);
                w.z = pk2(v[8 * j + 4] * rstd2 * gb.x, v[8 * j + 5] * rstd2 * gb.y); w.w = pk2(v[8 * j + 6] * rstd2 * gb.z, v[8 * j + 7] * rstd2 * gb.w); up[64 * j] = w; }
        }
    }
    SEAM(8);
    if (IN(9)) {
        pg8::Gemm g{U, (const bf16_t*)(ws + W_GU), T, 2 * DFF, 2048}; pg8::StaticOrder S; S.init(T, 2 * DFF, G, bx);
        pg8::EpiSwiglu E{(bf16_t*)(ws + A_ACT)}; pg8::gemm_phase<pg8::EpiSwiglu, pg8::StaticOrder, true, true>(lds, g, S, E);
    }
    SEAM(9);
    if (IN(10)) {
        pg8::Gemm g{(const bf16_t*)(ws + A_ACT), (const bf16_t*)(ws + W_DN), T, 2048, DFF}; pg8::StaticOrder S; S.init(T, 2048, G, bx);
        pg8::EpiPlain E{U, 2048}; pg8::gemm_phase<pg8::EpiPlain, pg8::StaticOrder, true, true>(lds, g, S, E);
    }
    SEAM(10);
    if (IN(11)) {
        const int lane = lane_id();
        const float* g3 = args.in[16];
        for (int m = gw; m < T; m += NGW) {
            const u32x4* mp = (const u32x4*)(U + (size_t)m * DM) + lane;
            float v[32]; float s = 0.f;
#pragma unroll
            for (int j = 0; j < 4; ++j) { const u32x4 w = mp[64 * j]; v[8 * j] = bflo(w.x); v[8 * j + 1] = bfhi(w.x); v[8 * j + 2] = bflo(w.y); v[8 * j + 3] = bfhi(w.y); v[8 * j + 4] = bflo(w.z); v[8 * j + 5] = bfhi(w.z); v[8 * j + 6] = bflo(w.w); v[8 * j + 7] = bfhi(w.w); }
#pragma unroll
            for (int e = 0; e < 32; ++e) s += v[e] * v[e];
            const float rstd = 1.0f / sqrtf(wave_sum(s) * (1.0f / DM) + EPS);
            const f32x4* hr = (const f32x4*)(h1 + (size_t)m * DM);
#pragma unroll
            for (int j = 0; j < 4; ++j)
#pragma unroll
                for (int q = 0; q < 2; ++q) { const int c4 = (lane + 64 * j) * 2 + q; const f32x4 xx = hr[c4], gg = ((const f32x4*)g3)[c4]; f32x4 hh;
                    hh.x = xx.x + v[8 * j + 4 * q] * rstd * gg.x; hh.y = xx.y + v[8 * j + 4 * q + 1] * rstd * gg.y; hh.z = xx.z + v[8 * j + 4 * q + 2] * rstd * gg.z; hh.w = xx.w + v[8 * j + 4 * q + 3] * rstd * gg.w;
                    ((f32x4*)(args.out + (size_t)m * DM))[c4] = hh; }
        }
    }
#undef IN
#undef SEAM
}

extern "C" void kernel_launch(void* const* d_in, const int* in_sizes, int n_in, void* d_out, int out_size, void* d_ws, size_t ws_size, hipStream_t stream) {
    static int grid = 0;
    if (grid == 0) {
        if (n_in != 17 || out_size != T * DM || ws_size < WS_NEED) { fprintf(stderr, "kernel_launch: unexpected shapes (n_in %d out %d ws %zu)\n", n_in, out_size, ws_size); grid = -1; return; }
        int dev = 0, cus = 0, per_cu = 0;
        hipGetDevice(&dev); hipDeviceGetAttribute(&cus, hipDeviceAttributeMultiprocessorCount, dev);
        hipFuncSetAttribute((const void*)mk_fwd, hipFuncAttributeMaxDynamicSharedMemorySize, LDS_BYTES);
        hipOccupancyMaxActiveBlocksPerMultiprocessor(&per_cu, (const void*)mk_fwd, 512, LDS_BYTES);
        (void)hipGetLastError();
        if (per_cu < 1) per_cu = 1;
        grid = cus;
    }
    if (grid < 0) return;
#ifdef EXP_MEMSET_OUT
    (void)hipMemsetAsync(d_out, 0, (size_t)out_size * 4, stream);
#endif
#ifdef EXP_MEMSET_ALL
    (void)hipMemsetAsync(d_ws, 0xAA, WS_NEED, stream);
#endif
#ifdef EXP_MEMSET_QKV
    (void)hipMemsetAsync((char*)d_ws + A_QSB, 0, (size_t)192 * MiB, stream);
#endif
    Args a{};
    for (int i = 0; i < 17; ++i) a.in[i] = (const float*)d_in[i];
    a.out = (float*)d_out; a.ws = (unsigned char*)d_ws;
    for (int i = 0; i < 32; ++i) a.invf[i] = (float)pow(10000.0, -(double)i / 32.0);
#if MK_COOP
    a.ph_lo = 0; a.ph_hi = NPH;
    void* kargs[] = {&a};
    hipError_t e = hipLaunchCooperativeKernel((const void*)mk_fwd, dim3(grid), dim3(512), kargs, LDS_BYTES, stream);
    if (e != hipSuccess) fprintf(stderr, "cooperative launch failed: %s (grid %d)\n", hipGetErrorString(e), grid);
#else
    for (int p = 0; p < NPH; ++p) { a.ph_lo = p; a.ph_hi = p + 1; hipLaunchKernelGGL(mk_fwd, dim3(grid), dim3(512), LDS_BYTES, stream, a); }
#endif
}
```

```cpp
#include <hip/hip_runtime.h>
#include <cstdio>
#include <cstdint>
#include <cmath>
namespace pg8 {
#define PG8_LAS __attribute__((address_space(3)))
typedef unsigned short bf16_t;
typedef short bf16x8 __attribute__((ext_vector_type(8)));
typedef float f32x4 __attribute__((ext_vector_type(4)));
typedef unsigned u32x4 __attribute__((ext_vector_type(4)));
constexpr int BM = 256, BK = 64, HALF = 128, HTB = HALF * BK * 2  , STAGE_BYTES = 8 * HTB, NXCD = 8, WGM = 8;

__host__ __device__ __forceinline__ int lds_byte(int r, int c) { const int st = (r >> 4) * 2 + (c >> 5), rr = r & 15, cc = c & 31, ob = rr * 64 + cc * 2; return st * 1024 + (ob ^ (((ob >> 9) & 1) << 5)); }
__host__ __device__ __forceinline__ void stage_rc(int b, int& R, int& C) { const int st = b / 1024, sb = b % 1024, swz = sb ^ (((sb >> 9) & 1) << 5); R = (st >> 1) * 16 + swz / 64; C = (st & 1) * 32 + (swz % 64) / 2; }
__host__ __device__ __forceinline__ int perm32(int rho) { const int n = rho >> 4, i = rho & 15; return 8 * (i >> 2) + 4 * n + (i & 3); }

struct Unit { int pm, pn; };
struct Gemm { const bf16_t* A; const bf16_t* Bt; int M, N, K; };

struct StaticOrder {
    int nM, nN, nwg, G, c;
    __host__ __device__ void init(int M, int N, int G_, int c_) { nM = M / BM; nN = N / BM; nwg = nM * nN; G = G_; c = c_; }
    __host__ __device__ bool next(int i, Unit& u) const {
        const long L = (long)i * G + c; if (L >= nwg) return false;
        int wgid = (int)L; { const int q = nwg / NXCD, r = nwg % NXCD, xcd = wgid % NXCD, off = wgid / NXCD; wgid = (xcd < r ? xcd * (q + 1) : r * (q + 1) + (xcd - r) * q) + off; }
        const int nig = WGM * nN, gid = wgid / nig, fm = gid * WGM, gsz = (nM - fm) < WGM ? (nM - fm) : WGM;
        u.pm = fm + ((wgid % nig) % gsz); u.pn = (wgid % nig) / gsz; return true;
    }
    __device__ __forceinline__ void a_ready(const Unit&) const {}
    __device__ __forceinline__ void done(const Unit&) const {}
};

__device__ __forceinline__ unsigned cvt_pk_bf16(float lo, float hi) { typedef float f2_ __attribute__((ext_vector_type(2))); typedef __bf16 b2_ __attribute__((ext_vector_type(2))); f2_ v = {lo, hi}; b2_ b = __builtin_convertvector(v, b2_); return __builtin_bit_cast(unsigned, b); }
typedef float f32x2 __attribute__((ext_vector_type(2)));
__device__ __forceinline__ f32x2 gelu_pk(f32x2 v) {
    const f32x2 av = __builtin_elementwise_abs(v), d = av * 0.2316418882f + 1.0f;
    f32x2 t; t.x = __builtin_amdgcn_rcpf(d.x); t.y = __builtin_amdgcn_rcpf(d.y);
    f32x2 q = t * 0.5307027145f + (-0.7265760135f); q = q * t + 0.7107068705f; q = q * t + (-0.142248368f); q = q * t + 0.127414796f; q = q * t;
    const f32x2 s = (v * v) * (-0.72134752044f);
    f32x2 e; e.x = __builtin_amdgcn_exp2f(s.x); e.y = __builtin_amdgcn_exp2f(s.y);
    const f32x2 m = v * (q * e), r = v - m;
    f32x2 o; o.x = v.x < 0.f ? m.x : r.x; o.y = v.y < 0.f ? m.y : r.y; return o;
}

template <class Epi, class Sched, bool ALIGN_EPI = false, bool SP2 = false>
__device__ __forceinline__ void gemm_phase(PG8_LAS unsigned char* lds, const Gemm g, const Sched& S, const Epi& E) {
    const int tid = threadIdx.x, wid = __builtin_amdgcn_readfirstlane(tid >> 6), lane = tid & 63, wr = wid >> 2, wc = wid & 3, fr = lane & 15, fq = lane >> 4;
    const int K = g.K, nt = K / BK;
    unsigned voffA[2], voffB[2];
#pragma unroll
    for (int i = 0; i < 2; ++i) { int R, C; stage_rc(tid * 16 + i * 8192, R, C); const int Rb = Epi::PERM ? ((R & ~31) + perm32(R & 31)) : R;
        voffA[i] = (unsigned)(R * K + C) * 2u; voffB[i] = (unsigned)(Rb * K + C) * 2u; }
    const size_t kstep = (size_t)(BK * 2);
    const size_t hstep = (size_t)HALF * K * 2;
    const size_t tstep = 2 * hstep;
    const unsigned ldsw = (unsigned)wid * 1024u;
    const int aoff = lds_byte(wr * 64 + fr, fq * 8), boff = lds_byte(wc * 32 + fr, fq * 8);
#define PG8_SA(b, h) (((b) * 2 + (h)) * HTB)
#define PG8_SB(b, h) ((4 + (b) * 2 + (h)) * HTB)
#define PG8_STAGE(bufoff, gbase, voff) do { _Pragma("unroll") for (int _i = 0; _i < 2; ++_i) \
        __builtin_amdgcn_global_load_lds((const unsigned*)((const char*)(gbase) + (voff)[_i]), (PG8_LAS unsigned*)(lds + (bufoff) + ldsw + _i * 8192), 16, 0, 0); } while (0)
#define PG8_LDA(dst, b, h) do { _Pragma("unroll") for (int m = 0; m < 4; ++m) _Pragma("unroll") for (int k = 0; k < 2; ++k) dst[m][k] = *(const PG8_LAS bf16x8*)(lds + PG8_SA(b, h) + aoff + m * 2048 + k * 1024); } while (0)
#define PG8_LDB(dst, b, h) do { _Pragma("unroll") for (int n = 0; n < 2; ++n) _Pragma("unroll") for (int k = 0; k < 2; ++k) dst[n][k] = *(const PG8_LAS bf16x8*)(lds + PG8_SB(b, h) + boff + n * 2048 + k * 1024); } while (0)
#define PG8_MMA(ai, bj, At, Bt) do { __builtin_amdgcn_s_setprio(1); _Pragma("unroll") for (int m = 0; m < 4; ++m) _Pragma("unroll") for (int n = 0; n < 2; ++n) _Pragma("unroll") for (int k = 0; k < 2; ++k) \
        acc[ai][bj][m][n] = __builtin_amdgcn_mfma_f32_16x16x32_bf16(Bt[n][k], At[m][k], acc[ai][bj][m][n], 0, 0, 0); __builtin_amdgcn_s_setprio(0); } while (0)
#define PG8_WAIT_V(n) asm volatile("s_waitcnt vmcnt(" #n ")" ::: "memory")
#define PG8_WAIT_L(n) asm volatile("s_waitcnt lgkmcnt(" #n ")" ::: "memory")
#define PG8_BAR __builtin_amdgcn_s_barrier()
#define PG8_SCHED __builtin_amdgcn_sched_barrier(0)
    Unit cur, nxt; int ui = 0;
    if (!S.next(0, cur)) return;
    f32x4 acc[2][2][4][2];
#pragma unroll
    for (int a = 0; a < 2; ++a)
#pragma unroll
        for (int b = 0; b < 2; ++b)
#pragma unroll
            for (int m = 0; m < 4; ++m)
#pragma unroll
                for (int n = 0; n < 2; ++n) acc[a][b][m][n] = (f32x4){0.f, 0.f, 0.f, 0.f};
    bf16x8 At[4][2], B0[2][2], B1[2][2];
    const char* cA = (const char*)g.A + (size_t)cur.pm * tstep; const char* cB = (const char*)g.Bt + (size_t)cur.pn * tstep;
    S.a_ready(cur);
    if constexpr (SP2) {
        PG8_STAGE(PG8_SB(0, 0), cB, voffB); PG8_STAGE(PG8_SB(0, 1), cB + hstep, voffB); PG8_STAGE(PG8_SA(0, 0), cA, voffA); PG8_STAGE(PG8_SA(0, 1), cA + hstep, voffA);
        if (wr == 1) PG8_BAR;
        PG8_WAIT_V(2); PG8_BAR;
        PG8_STAGE(PG8_SB(1, 0), cB + kstep, voffB); PG8_STAGE(PG8_SA(1, 0), cA + kstep, voffA); PG8_STAGE(PG8_SB(1, 1), cB + hstep + kstep, voffB);
        PG8_WAIT_V(6); PG8_BAR;
    } else {
        PG8_STAGE(PG8_SB(0, 0), cB, voffB); PG8_STAGE(PG8_SA(0, 0), cA, voffA); PG8_STAGE(PG8_SB(0, 1), cB + hstep, voffB); PG8_STAGE(PG8_SA(0, 1), cA + hstep, voffA);
        if (wr == 1) PG8_BAR;
        PG8_WAIT_V(4); PG8_BAR;
        PG8_STAGE(PG8_SB(1, 0), cB + kstep, voffB); PG8_STAGE(PG8_SA(1, 0), cA + kstep, voffA); PG8_STAGE(PG8_SB(1, 1), cB + hstep + kstep, voffB);
        PG8_WAIT_V(6); PG8_BAR;
    }
    for (;;) {
        const bool has_next = S.next(ui + 1, nxt);
        const char* nA = has_next ? (const char*)g.A + (size_t)nxt.pm * tstep : cA; const char* nB = has_next ? (const char*)g.Bt + (size_t)nxt.pn * tstep : cB;
        for (int t = 0; t < nt; t += 2) {
            const bool last = (t == nt - 2);
            const char* a1 = cA + (size_t)(t + 1) * kstep;
            const char* a2 = last ? nA : cA + (size_t)(t + 2) * kstep; const char* b2 = last ? nB : cB + (size_t)(t + 2) * kstep;
            const char* a3 = a2 + kstep; const char* b3 = b2 + kstep;
            if (last && has_next) S.a_ready(nxt);
            if constexpr (SP2) {
            PG8_LDB(B0, 0, 0); PG8_LDB(B1, 0, 1); PG8_SCHED; PG8_LDA(At, 0, 0); PG8_STAGE(PG8_SA(1, 1), a1 + hstep, voffA);
            PG8_WAIT_V(8); PG8_WAIT_L(0); PG8_BAR; PG8_MMA(0, 0, At, B0); PG8_MMA(0, 1, At, B1); PG8_BAR; PG8_SCHED;
            PG8_LDA(At, 0, 1); PG8_STAGE(PG8_SB(0, 0), b2, voffB); PG8_STAGE(PG8_SB(0, 1), b2 + hstep, voffB); PG8_STAGE(PG8_SA(0, 0), a2, voffA);
            PG8_WAIT_V(8); PG8_WAIT_L(0); PG8_BAR; PG8_MMA(1, 0, At, B0); PG8_MMA(1, 1, At, B1); PG8_BAR; PG8_SCHED;
            PG8_LDB(B0, 1, 0); PG8_LDB(B1, 1, 1); PG8_SCHED; PG8_LDA(At, 1, 0); PG8_STAGE(PG8_SA(0, 1), a2 + hstep, voffA);
            PG8_WAIT_V(8); PG8_WAIT_L(0); PG8_BAR; PG8_MMA(0, 0, At, B0); PG8_MMA(0, 1, At, B1); PG8_BAR; PG8_SCHED;
            PG8_LDA(At, 1, 1); PG8_STAGE(PG8_SB(1, 0), b3, voffB); PG8_STAGE(PG8_SB(1, 1), b3 + hstep, voffB); PG8_STAGE(PG8_SA(1, 0), a3, voffA);
            PG8_WAIT_V(8); PG8_WAIT_L(0); PG8_BAR; PG8_MMA(1, 0, At, B0); PG8_MMA(1, 1, At, B1); PG8_BAR; PG8_SCHED;
            } else {
            PG8_LDB(B0, 0, 0); PG8_SCHED; PG8_LDA(At, 0, 0); PG8_STAGE(PG8_SA(1, 1), a1 + hstep, voffA);
            PG8_WAIT_L(8); PG8_BAR; PG8_WAIT_L(0); PG8_MMA(0, 0, At, B0); PG8_BAR; PG8_SCHED;
            PG8_LDB(B1, 0, 1); PG8_STAGE(PG8_SB(0, 0), b2, voffB);
            PG8_BAR; PG8_WAIT_L(0); PG8_MMA(0, 1, At, B1); PG8_BAR;
            PG8_LDA(At, 0, 1); PG8_STAGE(PG8_SA(0, 0), a2, voffA);
            PG8_BAR; PG8_WAIT_L(0); PG8_MMA(1, 0, At, B0); PG8_BAR; PG8_SCHED;
            PG8_STAGE(PG8_SB(0, 1), b2 + hstep, voffB);
            PG8_WAIT_V(6); PG8_BAR; PG8_MMA(1, 1, At, B1); PG8_BAR;
            PG8_LDB(B0, 1, 0); PG8_SCHED; PG8_LDA(At, 1, 0); PG8_STAGE(PG8_SA(0, 1), a2 + hstep, voffA);
            PG8_WAIT_L(8); PG8_BAR; PG8_WAIT_L(0); PG8_MMA(0, 0, At, B0); PG8_BAR; PG8_SCHED;
            PG8_LDB(B1, 1, 1); PG8_STAGE(PG8_SB(1, 0), b3, voffB);
            PG8_BAR; PG8_WAIT_L(0); PG8_MMA(0, 1, At, B1); PG8_BAR;
            PG8_LDA(At, 1, 1); PG8_STAGE(PG8_SA(1, 0), a3, voffA);
            PG8_BAR; PG8_WAIT_L(0); PG8_MMA(1, 0, At, B0); PG8_BAR; PG8_SCHED;
            PG8_STAGE(PG8_SB(1, 1), b3 + hstep, voffB);
            PG8_WAIT_V(6); PG8_BAR; PG8_MMA(1, 1, At, B1); PG8_BAR;
            }
        }
        if constexpr (ALIGN_EPI) { if (wr == 0) PG8_BAR; }
        if constexpr (!Epi::AFTER_DRAIN) { E(acc, cur, wr, wc, fr, fq); S.done(cur); }
        if (!has_next) break;
#pragma unroll
        for (int a = 0; a < 2; ++a)
#pragma unroll
            for (int b = 0; b < 2; ++b)
#pragma unroll
                for (int m = 0; m < 4; ++m)
#pragma unroll
                    for (int n = 0; n < 2; ++n) acc[a][b][m][n] = (f32x4){0.f, 0.f, 0.f, 0.f};
        cur = nxt; cA = nA; cB = nB; ++ui;
        if constexpr (ALIGN_EPI) { if (wr == 1) PG8_BAR; }
    }
    PG8_WAIT_V(0);
    if constexpr (!ALIGN_EPI) { if (wr == 0) PG8_BAR; }
    PG8_BAR;
    if constexpr (Epi::AFTER_DRAIN) { E.fused(acc, cur, wr, wc, fr, fq, lds, wid, lane); S.done(cur); }
#undef PG8_SA
#undef PG8_SB
#undef PG8_STAGE
#undef PG8_LDA
#undef PG8_LDB
#undef PG8_MMA
#undef PG8_WAIT_V
#undef PG8_WAIT_L
#undef PG8_BAR
#undef PG8_SCHED
}
}
#define LAS __attribute__((address_space(3)))
typedef pg8::bf16_t bf16_t;
typedef short bf16x8 __attribute__((ext_vector_type(8)));
typedef short s16x4 __attribute__((ext_vector_type(4)));
typedef float f32x4 __attribute__((ext_vector_type(4)));
typedef float f32x16 __attribute__((ext_vector_type(16)));
typedef unsigned u32x4 __attribute__((ext_vector_type(4)));
typedef unsigned u32x2 __attribute__((ext_vector_type(2)));

constexpr int BATCH = 2, SEQ = 16384, T = BATCH * SEQ, DM = 2048, DFF = 5632;
constexpr int N1 = 8704;
constexpr float EPS = 1e-6f;
constexpr float LOG2E = 1.4426950408889634f, LN2 = 0.6931471805599453f;
constexpr float SB_SCALE = 0.08838834764831845f;
constexpr float MLA_C2 = 0.07216878364870323f * LOG2E;
constexpr float SB_EXIT = -110.0f;

constexpr size_t MiB = 1u << 20;
constexpr size_t W_IN = 1 * MiB;
constexpr size_t W_UQ = W_IN + (size_t)N1 * 2048 * 2;
constexpr size_t W_UKV = W_UQ + (size_t)1536 * 768 * 2;
constexpr size_t W_OSB = W_UKV + (size_t)2048 * 512 * 2;
constexpr size_t W_OMLA = W_OSB + (size_t)2048 * 1024 * 2;
constexpr size_t W_OUT = W_OMLA + (size_t)2048 * 1024 * 2;
constexpr size_t W_GU = W_OUT + (size_t)2048 * 2048 * 2;
constexpr size_t W_DN = W_GU + (size_t)11264 * 2048 * 2;
constexpr size_t W_END = W_DN + (size_t)2048 * 5632 * 2;
static_assert(W_END <= 122 * MiB, "weights region");
constexpr size_t A_U = 122 * MiB;
constexpr size_t A_QSB = 250 * MiB;
constexpr size_t A_KSB = 314 * MiB;
constexpr size_t A_VSB = 378 * MiB;
constexpr size_t A_TMP = A_KSB;
constexpr size_t A_QLAT = 442 * MiB;
constexpr size_t A_KVLAT = 490 * MiB;
constexpr size_t A_MLAO = A_QLAT;
constexpr size_t A_KR = 522 * MiB;
constexpr size_t A_KROPE = 530 * MiB;
constexpr size_t A_CS = 534 * MiB;
constexpr size_t A_Q = 542 * MiB;
constexpr size_t A_KN = 638 * MiB;
constexpr size_t A_VM = 702 * MiB;
constexpr size_t A_MIXED = A_Q;
constexpr size_t A_ACT = 250 * MiB;
constexpr size_t A_SBO = A_U;
constexpr size_t A_GATES = 766 * MiB;
constexpr size_t WS_NEED = 1022 * MiB;
static_assert(A_KSB - A_QSB == (size_t)T * 2048 && A_VSB - A_KSB == (size_t)T * 2048 && A_VM - A_KN == (size_t)T * 2048, "contiguous q/k/v");
static_assert(A_ACT + (size_t)T * DFF * 2 <= WS_NEED && A_VM + (size_t)T * 1024 * 2 <= WS_NEED, "ws map");

constexpr int LDS_BYTES = 147456;

__device__ __forceinline__ unsigned f2bf(float f) { unsigned u = __builtin_bit_cast(unsigned, f); return (u + 0x7fffu + ((u >> 16) & 1u)) >> 16; }
__device__ __forceinline__ unsigned pk2(float lo, float hi) { return f2bf(lo) | (f2bf(hi) << 16); }
__device__ __forceinline__ float bflo(unsigned w) { return __builtin_bit_cast(float, w << 16); }
__device__ __forceinline__ float bfhi(unsigned w) { return __builtin_bit_cast(float, w & 0xffff0000u); }
__device__ __forceinline__ float ex2(float x) { return __builtin_amdgcn_exp2f(x); }
__device__ __forceinline__ float sigmoidf_(float x) { return __builtin_amdgcn_rcpf(1.0f + ex2(-x * LOG2E)); }
__device__ __forceinline__ int lane_id() { int l; asm volatile("v_mbcnt_lo_u32_b32 %0, -1, 0\n\tv_mbcnt_hi_u32_b32 %0, -1, %0" : "=v"(l)); return l; }
__device__ __forceinline__ float wave_sum(float v) {
#pragma unroll
    for (int o = 1; o < 64; o <<= 1) v += __shfl_xor(v, o);
    return v;
}

namespace pg8 {
typedef const f32x4 (&AccRef)[2][2][4][2];
__device__ __forceinline__ void store_tile_bf16(AccRef acc, bf16_t* base, int ld, int rowb, int c0, float sc) {
#pragma unroll
    for (int ai = 0; ai < 2; ++ai)
#pragma unroll
        for (int m = 0; m < 4; ++m) { bf16_t* rowp = base + (size_t)(rowb + ai * HALF + m * 16) * ld + c0;
#pragma unroll
            for (int bj = 0; bj < 2; ++bj) { const f32x4 v0 = acc[ai][bj][m][0] * sc, v1 = acc[ai][bj][m][1] * sc; u32x4 w;
                w.x = cvt_pk_bf16(v0[0], v0[1]); w.y = cvt_pk_bf16(v0[2], v0[3]); w.z = cvt_pk_bf16(v1[0], v1[1]); w.w = cvt_pk_bf16(v1[2], v1[3]);
                *(u32x4*)(rowp + bj * HALF) = w; } }
}
struct Epi1 {
    static constexpr bool PERM = true, AFTER_DRAIN = false;
    bf16_t *qkv  , *qlat, *kvlat, *gates; float* kr; const float* bgate;
    __device__ __forceinline__ void operator()(AccRef acc, const Unit& u, int wr, int wc, int fr, int fq) const {
        const int pn = u.pn, rowb = u.pm * BM + wr * 64 + fr, cw = wc * 32 + 8 * fq;
        if (pn < 12) { bf16_t* base = qkv + (size_t)(pn >> 2) * ((size_t)T * 1024); store_tile_bf16(acc, base, 1024, rowb, (pn & 3) * 256 + cw, pn < 4 ? SB_SCALE : 1.0f); }
        else if (pn < 15) store_tile_bf16(acc, qlat, 768, rowb, (pn - 12) * 256 + cw, 1.0f);
        else if (pn < 17) store_tile_bf16(acc, kvlat, 512, rowb, (pn - 15) * 256 + cw, 1.0f);
        else if (pn < 33) {
            const int c0 = (pn - 17) * 256 + cw;
            f32x4 bv[2][2];
#pragma unroll
            for (int bj = 0; bj < 2; ++bj)
#pragma unroll
                for (int n = 0; n < 2; ++n) bv[bj][n] = *(const f32x4*)(bgate + c0 + bj * HALF + 4 * n);
#pragma unroll
            for (int ai = 0; ai < 2; ++ai)
#pragma unroll
                for (int m = 0; m < 4; ++m) { bf16_t* rowp = gates + (size_t)(rowb + ai * HALF + m * 16) * 4096 + c0;
#pragma unroll
                    for (int bj = 0; bj < 2; ++bj) { const f32x4 v0 = acc[ai][bj][m][0] + bv[bj][0], v1 = acc[ai][bj][m][1] + bv[bj][1]; u32x4 w;
                        w.x = cvt_pk_bf16(sigmoidf_(v0[0]), sigmoidf_(v0[1])); w.y = cvt_pk_bf16(sigmoidf_(v0[2]), sigmoidf_(v0[3]));
                        w.z = cvt_pk_bf16(sigmoidf_(v1[0]), sigmoidf_(v1[1])); w.w = cvt_pk_bf16(sigmoidf_(v1[2]), sigmoidf_(v1[3]));
                        *(u32x4*)(rowp + bj * HALF) = w; } }
        } else if (wc < 2) {
#pragma unroll
            for (int ai = 0; ai < 2; ++ai)
#pragma unroll
                for (int m = 0; m < 4; ++m) { float* rowp = kr + (size_t)(rowb + ai * HALF + m * 16) * 64 + cw;
                    *(f32x4*)rowp = acc[ai][0][m][0]; *(f32x4*)(rowp + 4) = acc[ai][0][m][1]; }
        }
    }
};
struct EpiQ {
    static constexpr bool PERM = true, AFTER_DRAIN = false;
    bf16_t* q; const float* cs;
    __device__ __forceinline__ void operator()(AccRef acc, const Unit& u, int wr, int wc, int fr, int fq) const {
        const int pn = u.pn, rowb = u.pm * BM + wr * 64 + fr, cw = wc * 32 + 8 * fq;
        if (pn < 4) {
#pragma unroll
            for (int ai = 0; ai < 2; ++ai)
#pragma unroll
                for (int m = 0; m < 4; ++m) { bf16_t* rowp = q + (size_t)(rowb + ai * HALF + m * 16) * 1536 + cw;
#pragma unroll
                    for (int bj = 0; bj < 2; ++bj) { const f32x4 v0 = acc[ai][bj][m][0] * MLA_C2, v1 = acc[ai][bj][m][1] * MLA_C2; u32x4 w;
                        w.x = cvt_pk_bf16(v0[0], v0[1]); w.y = cvt_pk_bf16(v0[2], v0[3]); w.z = cvt_pk_bf16(v1[0], v1[1]); w.w = cvt_pk_bf16(v1[2], v1[3]);
                        *(u32x4*)(rowp + (2 * pn + bj) * 192) = w; } }
        } else {
            const int head = (pn - 4) * 4 + wc, i0 = 8 * fq;
#pragma unroll
            for (int ai = 0; ai < 2; ++ai)
#pragma unroll
                for (int m = 0; m < 4; ++m) { const int row = rowb + ai * HALF + m * 16; const float* cp = cs + (size_t)row * 64 + i0;
                    const f32x4 c0 = *(const f32x4*)cp, c1 = *(const f32x4*)(cp + 4), s0 = *(const f32x4*)(cp + 32), s1 = *(const f32x4*)(cp + 36);
                    const f32x4 a0 = acc[ai][0][m][0], a1 = acc[ai][0][m][1], b0 = acc[ai][1][m][0], b1 = acc[ai][1][m][1];
                    const f32x4 o10 = (a0 * c0 - b0 * s0) * MLA_C2, o11 = (a1 * c1 - b1 * s1) * MLA_C2, o20 = (b0 * c0 + a0 * s0) * MLA_C2, o21 = (b1 * c1 + a1 * s1) * MLA_C2;
                    bf16_t* rowp = q + (size_t)row * 1536 + head * 192 + 128 + i0; u32x4 w;
                    w.x = cvt_pk_bf16(o10[0], o10[1]); w.y = cvt_pk_bf16(o10[2], o10[3]); w.z = cvt_pk_bf16(o11[0], o11[1]); w.w = cvt_pk_bf16(o11[2], o11[3]);
                    *(u32x4*)rowp = w;
                    w.x = cvt_pk_bf16(o20[0], o20[1]); w.y = cvt_pk_bf16(o20[2], o20[3]); w.z = cvt_pk_bf16(o21[0], o21[1]); w.w = cvt_pk_bf16(o21[2], o21[3]);
                    *(u32x4*)(rowp + 32) = w; }
        }
    }
};
struct EpiKV {
    static constexpr bool PERM = true, AFTER_DRAIN = false;
    bf16_t* kv;
    __device__ __forceinline__ void operator()(AccRef acc, const Unit& u, int wr, int wc, int fr, int fq) const {
        const int pn = u.pn; store_tile_bf16(acc, kv + (size_t)(pn >> 2) * ((size_t)T * 1024), 1024, u.pm * BM + wr * 64 + fr, (pn & 3) * 256 + wc * 32 + 8 * fq, 1.0f);
    }
};
struct EpiPlain {
    static constexpr bool PERM = true, AFTER_DRAIN = false;
    bf16_t* o; int ld;
    __device__ __forceinline__ void operator()(AccRef acc, const Unit& u, int wr, int wc, int fr, int fq) const {
        store_tile_bf16(acc, o, ld, u.pm * BM + wr * 64 + fr, u.pn * 256 + wc * 32 + 8 * fq, 1.0f);
    }
};
template <bool SECOND> struct EpiGate {
    static constexpr bool PERM = true, AFTER_DRAIN = false;
    const bf16_t* gates; bf16_t* tmp; bf16_t* out;
    __device__ __forceinline__ void operator()(AccRef acc, const Unit& u, int wr, int wc, int fr, int fq) const {
        const int rowb = u.pm * BM + wr * 64 + fr, c0 = u.pn * 256 + wc * 32 + 8 * fq;
#pragma unroll
        for (int ai = 0; ai < 2; ++ai)
#pragma unroll
            for (int m = 0; m < 4; ++m) { const size_t row = (size_t)(rowb + ai * HALF + m * 16);
#pragma unroll
                for (int bj = 0; bj < 2; ++bj) { const int c = c0 + bj * HALF;
                    const u32x4 g = *(const u32x4*)(gates + row * 4096 + (SECOND ? 2048 : 0) + c);
                    const f32x4 a0 = acc[ai][bj][m][0], a1 = acc[ai][bj][m][1];
                    float r[8] = {a0[0] * bflo(g.x), a0[1] * bfhi(g.x), a0[2] * bflo(g.y), a0[3] * bfhi(g.y), a1[0] * bflo(g.z), a1[1] * bfhi(g.z), a1[2] * bflo(g.w), a1[3] * bfhi(g.w)};
                    if (SECOND) { const u32x4 t = *(const u32x4*)(tmp + row * 2048 + c);
                        r[0] += bflo(t.x); r[1] += bfhi(t.x); r[2] += bflo(t.y); r[3] += bfhi(t.y); r[4] += bflo(t.z); r[5] += bfhi(t.z); r[6] += bflo(t.w); r[7] += bfhi(t.w); }
                    u32x4 w; w.x = cvt_pk_bf16(r[0], r[1]); w.y = cvt_pk_bf16(r[2], r[3]); w.z = cvt_pk_bf16(r[4], r[5]); w.w = cvt_pk_bf16(r[6], r[7]);
                    *(u32x4*)((SECOND ? out : tmp) + row * 2048 + c) = w; } }
    }
};
struct EpiSwiglu {
    static constexpr bool PERM = true, AFTER_DRAIN = false;
    bf16_t* act;
    __device__ __forceinline__ void operator()(AccRef acc, const Unit& u, int wr, int wc, int fr, int fq) const {
        const int rowb = u.pm * BM + wr * 64 + fr, c0 = u.pn * 128 + wc * 32 + 8 * fq;
#pragma unroll
        for (int ai = 0; ai < 2; ++ai)
#pragma unroll
            for (int m = 0; m < 4; ++m) { const f32x4 g0 = acc[ai][0][m][0], g1 = acc[ai][0][m][1], u0 = acc[ai][1][m][0], u1 = acc[ai][1][m][1]; float r[8];
#pragma unroll
                for (int k = 0; k < 4; ++k) { r[k] = g0[k] * sigmoidf_(g0[k]) * u0[k]; r[4 + k] = g1[k] * sigmoidf_(g1[k]) * u1[k]; }
                u32x4 w; w.x = cvt_pk_bf16(r[0], r[1]); w.y = cvt_pk_bf16(r[2], r[3]); w.z = cvt_pk_bf16(r[4], r[5]); w.w = cvt_pk_bf16(r[6], r[7]);
                *(u32x4*)(act + (size_t)(rowb + ai * HALF + m * 16) * DFF + c0) = w; }
    }
};
}

namespace att {
constexpr int VSTR = 320, VOFF = 64 * 400, STAGE = VOFF + 64 * VSTR  , FLAG_OFF = 2 * STAGE;
typedef short v4i16_t __attribute__((ext_vector_type(4)));
__device__ __forceinline__ int crow(int r, int hi) { return (r & 3) + 8 * (r >> 2) + 4 * hi; }
__device__ __forceinline__ unsigned cvtpk(float lo, float hi) { typedef float f2 __attribute__((ext_vector_type(2))); typedef __bf16 b2 __attribute__((ext_vector_type(2))); f2 v = {lo, hi}; b2 b = __builtin_convertvector(v, b2); return __builtin_bit_cast(unsigned, b); }
__device__ __forceinline__ s16x4 vtr(const LAS unsigned char* p) { return __builtin_bit_cast(s16x4, __builtin_amdgcn_ds_read_tr16_b64_v4i16((LAS v4i16_t*)p)); }
__device__ __forceinline__ float partner(float x, int hi) { auto rr = __builtin_amdgcn_permlane32_swap(__float_as_uint(x), __float_as_uint(x), false, false); return __uint_as_float(hi ? rr[0] : rr[1]); }

#ifndef EXP_SKIP_SB
#define EXP_SKIP_SB 0
#endif
template <bool MLA>
__device__ __forceinline__ void attn_unit(LAS unsigned char* lds, const int b, const int h, const int qb,
        const bf16_t* Q, const bf16_t* __restrict__ K, const bf16_t* __restrict__ KR, const bf16_t* __restrict__ V, bf16_t* O) {
    constexpr int DK = MLA ? 192 : 128, NKS = DK / 16, KSTR = DK * 2 + 16, QP = MLA ? 1536 : 1024;
    const int tid = threadIdx.x, lane = tid & 63, r32 = lane & 31, hi = lane >> 5;
    const int wid = __builtin_amdgcn_readfirstlane(tid >> 6);
    const size_t rowbase = (size_t)b * SEQ;
    const int q0 = qb * 256, NT = 4 * qb + 4, tdiag = 4 * qb + (wid >> 1);
    if (!MLA && EXP_SKIP_SB) { bf16_t* orow_ = O + (rowbase + q0 + wid * 32 + r32) * 1024 + h * 128 + 4 * hi;
        for (int dt = 0; dt < 4; ++dt) for (int g = 0; g < 4; ++g) { u32x2 w; w.x = 0x3f803f00u + (unsigned)((r32 + dt + g) & 7) * 0x00010001u; w.y = 0xbf803e80u; *(u32x2*)(orow_ + dt * 32 + 8 * g) = w; }
        return; }
    const int srow = tid >> 4, sch = tid & 15;
    const bf16_t* kg = K + (rowbase + srow) * 1024 + h * 128 + sch * 8;
    const bf16_t* vg = V + (rowbase + srow) * 1024 + h * 128 + sch * 8;
    const bf16_t* rg = KR + (rowbase + (tid >> 3)) * 64 + (tid & 7) * 8;
    const int kdst = srow * KSTR + sch * 16, vdst = VOFF + srow * VSTR + sch * 16, rdst = (tid >> 3) * KSTR + 256 + (tid & 7) * 16;
    u32x4 sk0, sk1, sv0, sv1, sr;
#define ATT_LOAD(tt) do { const size_t o_ = (size_t)(tt) * 65536; sk0 = *(const u32x4*)(kg + o_); sk1 = *(const u32x4*)(kg + o_ + 32768); sv0 = *(const u32x4*)(vg + o_); sv1 = *(const u32x4*)(vg + o_ + 32768); \
        if (MLA) sr = *(const u32x4*)(rg + (size_t)(tt) * 4096); } while (0)
#define ATT_STORE(so) do { *(LAS u32x4*)(lds + (so) + kdst) = sk0; *(LAS u32x4*)(lds + (so) + kdst + 32 * KSTR) = sk1; *(LAS u32x4*)(lds + (so) + vdst) = sv0; *(LAS u32x4*)(lds + (so) + vdst + 32 * VSTR) = sv1; \
        if (MLA) *(LAS u32x4*)(lds + (so) + rdst) = sr; } while (0)
    const int t0 = MLA ? 0 : NT - 1, tstep = MLA ? 1 : -1;
    ATT_LOAD(t0);
    bf16x8 qf[NKS];
    { const bf16_t* qrow = Q + (rowbase + q0 + wid * 32 + r32) * QP + h * DK + hi * 8;
#pragma unroll
      for (int d0 = 0; d0 < NKS; ++d0) qf[d0] = *(const bf16x8*)(qrow + d0 * 16); }
    f32x16 o[4];
#pragma unroll
    for (int i = 0; i < 4; ++i)
#pragma unroll
        for (int r = 0; r < 16; ++r) o[i][r] = 0.f;
    float m_ref = 0.f, lsum = 0.f, R = 0.f;
    const int kfb = r32 * KSTR + hi * 16;
    const int vfb = VOFF + (4 * hi + ((lane & 15) >> 2)) * VSTR + (((lane >> 4) & 1) * 16 + (lane & 3) * 4) * 2;
    volatile LAS unsigned* flags = (volatile LAS unsigned*)(lds + FLAG_OFF);
    ATT_STORE(0);
    __syncthreads();
    int t = t0;
    for (int it = 0; it < NT; ++it, t += tstep) {
        const int st = (it & 1) * STAGE;
        const bool more = it + 1 < NT;
        if (more) ATT_LOAD(t + tstep);
        if (MLA) { if (t <= tdiag) {
            f32x16 p0, p1;
#pragma unroll
            for (int r = 0; r < 16; ++r) { p0[r] = -m_ref; p1[r] = -m_ref; }
#pragma unroll
            for (int d0 = 0; d0 < NKS; ++d0) {
                const bf16x8 k0 = *(const LAS bf16x8*)(lds + st + kfb + d0 * 32);
                p0 = __builtin_amdgcn_mfma_f32_32x32x16_bf16(k0, qf[d0], p0, 0, 0, 0);
            }
            float tmA = p0[0];
#pragma unroll
            for (int r = 1; r < 16; ++r) tmA = fmaxf(tmA, p0[r]);
            tmA = fmaxf(tmA, partner(tmA, hi));
            float dA = 0.f; bool flagA = false;
            if (it == 0 || __any(tmA > 8.0f)) {
                dA = (it == 0) ? tmA : fmaxf(tmA, 0.f);
                if (it != 0) { const float sc = ex2(-dA); lsum *= sc;
#pragma unroll
                    for (int i = 0; i < 4; ++i)
#pragma unroll
                        for (int r = 0; r < 16; ++r) o[i][r] *= sc; }
                m_ref += dA; flagA = true;
#pragma unroll
                for (int r = 0; r < 16; ++r) p0[r] -= dA;
            }
#pragma unroll
            for (int d0 = 0; d0 < NKS; ++d0) {
                const bf16x8 k1 = *(const LAS bf16x8*)(lds + st + kfb + 32 * KSTR + d0 * 32);
                p1 = __builtin_amdgcn_mfma_f32_32x32x16_bf16(k1, qf[d0], p1, 0, 0, 0);
            }
            { float ps = 0.f;
#pragma unroll
              for (int r = 0; r < 16; ++r) { p0[r] = ex2(p0[r]); ps += p0[r]; }
              lsum += ps; }
            if (flagA) {
#pragma unroll
                for (int r = 0; r < 16; ++r) p1[r] -= dA;
            }
            float tmB = p1[0];
#pragma unroll
            for (int r = 1; r < 16; ++r) tmB = fmaxf(tmB, p1[r]);
            tmB = fmaxf(tmB, partner(tmB, hi));
            if (__any(tmB > 8.0f)) {
                const float dB = fmaxf(tmB, 0.f), sc = ex2(-dB); lsum *= sc; m_ref += dB;
#pragma unroll
                for (int i = 0; i < 4; ++i)
#pragma unroll
                    for (int r = 0; r < 16; ++r) o[i][r] *= sc;
#pragma unroll
                for (int r = 0; r < 16; ++r) { p0[r] *= sc; p1[r] -= dB; }
            }
            bf16x8 pf[4];
            { u32x4 w;
              w.x = cvtpk(p0[0], p0[1]); w.y = cvtpk(p0[2], p0[3]); w.z = cvtpk(p0[4], p0[5]); w.w = cvtpk(p0[6], p0[7]); pf[0] = __builtin_bit_cast(bf16x8, w);
              w.x = cvtpk(p0[8], p0[9]); w.y = cvtpk(p0[10], p0[11]); w.z = cvtpk(p0[12], p0[13]); w.w = cvtpk(p0[14], p0[15]); pf[1] = __builtin_bit_cast(bf16x8, w); }
#pragma unroll
            for (int s = 0; s < 2; ++s)
#pragma unroll
                for (int dt = 0; dt < 4; ++dt) {
                    const s16x4 lo = vtr(lds + st + vfb + s * 16 * VSTR + dt * 64);
                    const s16x4 hh = vtr(lds + st + vfb + s * 16 * VSTR + dt * 64 + 8 * VSTR);
                    const bf16x8 vf = {lo[0], lo[1], lo[2], lo[3], hh[0], hh[1], hh[2], hh[3]};
                    o[dt] = __builtin_amdgcn_mfma_f32_32x32x16_bf16(vf, pf[s], o[dt], 0, 0, 0);
                }
            { float ps = 0.f;
#pragma unroll
              for (int r = 0; r < 16; ++r) { p1[r] = ex2(p1[r]); ps += p1[r]; }
              lsum += ps;
              u32x4 w;
              w.x = cvtpk(p1[0], p1[1]); w.y = cvtpk(p1[2], p1[3]); w.z = cvtpk(p1[4], p1[5]); w.w = cvtpk(p1[6], p1[7]); pf[2] = __builtin_bit_cast(bf16x8, w);
              w.x = cvtpk(p1[8], p1[9]); w.y = cvtpk(p1[10], p1[11]); w.z = cvtpk(p1[12], p1[13]); w.w = cvtpk(p1[14], p1[15]); pf[3] = __builtin_bit_cast(bf16x8, w); }
#pragma unroll
            for (int s = 2; s < 4; ++s)
#pragma unroll
                for (int dt = 0; dt < 4; ++dt) {
                    const s16x4 lo = vtr(lds + st + vfb + s * 16 * VSTR + dt * 64);
                    const s16x4 hh = vtr(lds + st + vfb + s * 16 * VSTR + dt * 64 + 8 * VSTR);
                    const bf16x8 vf = {lo[0], lo[1], lo[2], lo[3], hh[0], hh[1], hh[2], hh[3]};
                    o[dt] = __builtin_amdgcn_mfma_f32_32x32x16_bf16(vf, pf[s], o[dt], 0, 0, 0);
                }
        } } else
        if (t <= tdiag) {
            f32x16 p0, p1;
#pragma unroll
            for (int r = 0; r < 16; ++r) { p0[r] = 0.f; p1[r] = 0.f; }
#pragma unroll
            for (int d0 = 0; d0 < NKS; ++d0) {
                const bf16x8 k0 = *(const LAS bf16x8*)(lds + st + kfb + d0 * 32);
                const bf16x8 k1 = *(const LAS bf16x8*)(lds + st + kfb + 32 * KSTR + d0 * 32);
                p0 = __builtin_amdgcn_mfma_f32_32x32x16_bf16(k0, qf[d0], p0, 0, 0, 0);
                p1 = __builtin_amdgcn_mfma_f32_32x32x16_bf16(k1, qf[d0], p1, 0, 0, 0);
            }
            if (MLA) {
                float tm = fmaxf(p0[0], p1[0]);
#pragma unroll
                for (int r = 1; r < 16; ++r) tm = fmaxf(tm, fmaxf(p0[r], p1[r]));
                tm = fmaxf(tm, partner(tm, hi));
                if (__any(tm > m_ref + 8.0f)) {
                    const float mn = fmaxf(m_ref, tm), sc = ex2(m_ref - mn);
                    lsum *= sc;
#pragma unroll
                    for (int i = 0; i < 4; ++i)
#pragma unroll
                        for (int r = 0; r < 16; ++r) o[i][r] *= sc;
                    m_ref = mn;
                }
                float ps = 0.f;
#pragma unroll
                for (int r = 0; r < 16; ++r) { p0[r] = ex2(p0[r] - m_ref); p1[r] = ex2(p1[r] - m_ref); ps += p0[r] + p1[r]; }
                lsum += ps;
            } else {
                const bool diag = (t == tdiag);
                const int qrel = (wid & 1) * 32 + r32;
                float lk[32];
#pragma unroll
                for (int x = 0; x < 32; ++x) {
                    const float z = x < 16 ? p0[x] : p1[x - 16];
                    const int kv = (x < 16 ? 0 : 32) + crow(x & 15, hi);
                    const bool valid = !diag || kv < qrel;
                    const float e = ex2(-fabsf(z) * LOG2E);
                    const float sp = fmaxf(z, 0.f) + LN2 * __builtin_amdgcn_logf(1.0f + e);
                    lk[x] = valid ? -sp : 0.f;
                }
                float gs[8], ot[8], ST[8];
#pragma unroll
                for (int k = 0; k < 8; ++k) { gs[k] = (lk[4 * k] + lk[4 * k + 1]) + (lk[4 * k + 2] + lk[4 * k + 3]); ot[k] = partner(gs[k], hi); }
                ST[7] = 0.f;
#pragma unroll
                for (int k = 6; k >= 0; --k) ST[k] = ST[k + 1] + (gs[k + 1] + ot[k + 1]);
                const float tot = ST[0] + (gs[0] + ot[0]);
#pragma unroll
                for (int k = 0; k < 8; ++k) {
                    const float s3 = R + ST[k] + (hi == 0 ? ot[k] : 0.f);
                    const float s2 = s3 + lk[4 * k + 3], s1 = s2 + lk[4 * k + 2], s0 = s1 + lk[4 * k + 1];
                    const float ss[4] = {s0, s1, s2, s3};
#pragma unroll
                    for (int i = 0; i < 4; ++i) {
                        const int x = 4 * k + i;
                        const float z = x < 16 ? p0[x] : p1[x - 16];
                        const int kv = (x < 16 ? 0 : 32) + crow(x & 15, hi);
                        const bool valid = !diag || kv < qrel;
                        const float w = valid ? ex2((z + lk[x] + ss[i]) * LOG2E) : 0.f;
                        if (x < 16) p0[x] = w; else p1[x - 16] = w;
                    }
                }
                R += tot;
            }
            bf16x8 pf[4];
            { u32x4 w;
              w.x = cvtpk(p0[0], p0[1]); w.y = cvtpk(p0[2], p0[3]); w.z = cvtpk(p0[4], p0[5]); w.w = cvtpk(p0[6], p0[7]); pf[0] = __builtin_bit_cast(bf16x8, w);
              w.x = cvtpk(p0[8], p0[9]); w.y = cvtpk(p0[10], p0[11]); w.z = cvtpk(p0[12], p0[13]); w.w = cvtpk(p0[14], p0[15]); pf[1] = __builtin_bit_cast(bf16x8, w);
              w.x = cvtpk(p1[0], p1[1]); w.y = cvtpk(p1[2], p1[3]); w.z = cvtpk(p1[4], p1[5]); w.w = cvtpk(p1[6], p1[7]); pf[2] = __builtin_bit_cast(bf16x8, w);
              w.x = cvtpk(p1[8], p1[9]); w.y = cvtpk(p1[10], p1[11]); w.z = cvtpk(p1[12], p1[13]); w.w = cvtpk(p1[14], p1[15]); pf[3] = __builtin_bit_cast(bf16x8, w); }
#pragma unroll
            for (int s = 0; s < 4; ++s)
#pragma unroll
                for (int dt = 0; dt < 4; ++dt) {
                    const s16x4 lo = vtr(lds + st + vfb + s * 16 * VSTR + dt * 64);
                    const s16x4 hh = vtr(lds + st + vfb + s * 16 * VSTR + dt * 64 + 8 * VSTR);
                    const bf16x8 vf = {lo[0], lo[1], lo[2], lo[3], hh[0], hh[1], hh[2], hh[3]};
                    o[dt] = __builtin_amdgcn_mfma_f32_32x32x16_bf16(vf, pf[s], o[dt], 0, 0, 0);
                }
        }
        if (!MLA) { const bool dn = __all(R <= SB_EXIT); if (lane == 0) flags[(it & 1) * 8 + wid] = dn ? 1u : 0u; }
        if (more) ATT_STORE(((it + 1) & 1) * STAGE);
        __syncthreads();
        if (!MLA) { unsigned a = 1u;
#pragma unroll
            for (int w = 0; w < 8; ++w) a &= flags[(it & 1) * 8 + w];
#ifndef EXP_NO_EXIT
            if (a) break;
#else
            if (a == 12345u) break;
#endif
            }
    }
#undef ATT_LOAD
#undef ATT_STORE
    float inv = 1.0f;
    if (MLA) inv = __builtin_amdgcn_rcpf(lsum + partner(lsum, hi));
    bf16_t* orow = O + (rowbase + q0 + wid * 32 + r32) * 1024 + h * 128 + 4 * hi;
#pragma unroll
    for (int dt = 0; dt < 4; ++dt)
#pragma unroll
        for (int g = 0; g < 4; ++g) { u32x2 w; w.x = cvtpk(o[dt][4 * g] * inv, o[dt][4 * g + 1] * inv); w.y = cvtpk(o[dt][4 * g + 2] * inv, o[dt][4 * g + 3] * inv);
            *(u32x2*)(orow + dt * 32 + 8 * g) = w; }
}
}

#include <hip/hip_cooperative_groups.h>
namespace cg = cooperative_groups;
#ifndef MK_COOP
#define MK_COOP 1
#endif
constexpr int NPH = 12;
struct Args { const float* in[17]; float* out; unsigned char* ws; float invf[32]; int ph_lo, ph_hi; };
static_assert(sizeof(Args) == 17 * 8 + 16 + 128 + 8, "Args has no padding");

__device__ __forceinline__ void transpose_item(const float* __restrict__ W, int K, int N, bf16_t* __restrict__ WT, int k0, int n0, int drow, LAS float* scr, int lane) {
#pragma unroll 8
    for (int i = 0; i < 32; ++i) { const int kk = 2 * i + (lane >> 5); scr[kk * 33 + (lane & 31)] = W[(size_t)(k0 + kk) * N + n0 + (lane & 31)]; }
    asm volatile("s_waitcnt lgkmcnt(0)" ::: "memory");
    const int c = lane & 7;
#pragma unroll
    for (int j = 0; j < 4; ++j) { const int n = (lane >> 3) + 8 * j; const LAS float* s = scr + (8 * c) * 33 + n;
        u32x4 o; o.x = pk2(s[0 * 33], s[1 * 33]); o.y = pk2(s[2 * 33], s[3 * 33]); o.z = pk2(s[4 * 33], s[5 * 33]); o.w = pk2(s[6 * 33], s[7 * 33]);
        *(u32x4*)(WT + (size_t)(drow + n) * K + k0 + 8 * c) = o; }
    asm volatile("s_waitcnt lgkmcnt(0)" ::: "memory");
}
__device__ __forceinline__ int dst_row(int id, int n0) {
    switch (id) {
    case 0: return n0 < 4352 ? n0 : (n0 < 4416 ? 8448 + (n0 - 4352) : 4352 + (n0 - 4416));
    case 1: { const int h = n0 / 192, j = n0 % 192; return j < 128 ? h * 128 + j : 1024 + (h >> 2) * 256 + (j >= 160 ? 128 : 0) + (h & 3) * 32; }
    case 2: { const int h = n0 >> 8, j = n0 & 255; return j < 128 ? h * 128 + j : 1024 + h * 128 + (j - 128); }
    case 6: { const int up = n0 >= DFF, j = up ? n0 - DFF : n0; return (j >> 7) * 256 + (up ? 128 : 0) + (j & 127); }
    default: return n0;
    }
}

__global__ void __launch_bounds__(512) mk_fwd(Args args) {
    __builtin_assume(__builtin_amdgcn_workitem_id_y() == 0); __builtin_assume(__builtin_amdgcn_workitem_id_z() == 0);
    extern __shared__ __attribute__((aligned(16))) unsigned char lds_raw[];
    LAS unsigned char* lds = (LAS unsigned char*)lds_raw;
    cg::grid_group grid = cg::this_grid();
    const int wave = __builtin_amdgcn_readfirstlane(threadIdx.x >> 6);
    const int G = gridDim.x, bx = blockIdx.x;
    const int vcu = (G % 8 == 0) ? (bx % 8) * (G / 8) + bx / 8 : bx;
    const int gw = vcu * 8 + wave, NGW = G * 8;
    unsigned char* ws = args.ws;
    const int lo = args.ph_lo, hi_ = args.ph_hi;
#define IN(k) (lo <= (k) && (k) < hi_)
#define SEAM(k) do { if (IN(k) && IN((k) + 1)) grid.sync(); } while (0)
    bf16_t* U = (bf16_t*)(ws + A_U);
    bf16_t* gates = (bf16_t*)(ws + A_GATES);
    float* h1 = (float*)(ws + A_GATES);

    if (IN(0)) {
        const int lane = lane_id();
        LAS float* scr = (LAS float*)(lds + wave * 16384);
        int base = 0;
#define CONV(id, Wp, Kk, Nn, Off) do { const int nblk = (Nn) / 32, items = ((Kk) / 64) * nblk; \
            for (int it = gw - base; it < items; it += NGW) { if (it < 0) continue; \
                const int kb = it / nblk, nb = it % nblk; transpose_item((Wp), (Kk), (Nn), (bf16_t*)(ws + (Off)), 64 * kb, 32 * nb, dst_row((id), 32 * nb), scr, lane); } \
            base = (base + items) % NGW; } while (0)
        CONV(0, args.in[3], 2048, 8512, W_IN); CONV(1, args.in[6], 768, 1536, W_UQ); CONV(2, args.in[8], 512, 2048, W_UKV); CONV(3, args.in[9], 1024, 2048, W_OSB);
        CONV(4, args.in[10], 1024, 2048, W_OMLA); CONV(5, args.in[11], 2048, 2048, W_OUT); CONV(6, args.in[14], 2048, 2 * DFF, W_GU); CONV(7, args.in[15], DFF, 2048, W_DN);
#undef CONV
        const float* g = args.in[2];
        for (int m = gw; m < T; m += NGW) {
            const f32x4* xr = (const f32x4*)(args.in[0] + (size_t)m * DM) + lane; f32x4 v[8]; float s = 0.f;
#pragma unroll
            for (int j = 0; j < 8; ++j) { v[j] = xr[64 * j]; s += (v[j].x * v[j].x + v[j].y * v[j].y) + (v[j].z * v[j].z + v[j].w * v[j].w); }
            const float rstd = 1.0f / sqrtf(wave_sum(s) * (1.0f / DM) + EPS);
            u32x2* o8 = (u32x2*)(U + (size_t)m * DM) + lane;
#pragma unroll
            for (int j = 0; j < 8; ++j) { const f32x4 gg = *((const f32x4*)g + lane + 64 * j); u32x2 w; w.x = pk2(v[j].x * rstd * gg.x, v[j].y * rstd * gg.y); w.y = pk2(v[j].z * rstd * gg.z, v[j].w * rstd * gg.w); o8[64 * j] = w; }
        }
    }
    SEAM(0);
    if (IN(1)) {
        pg8::Gemm g{U, (const bf16_t*)(ws + W_IN), T, N1, 2048}; pg8::StaticOrder S; S.init(T, N1, G, bx);
        pg8::Epi1 E{(bf16_t*)(ws + A_QSB), (bf16_t*)(ws + A_QLAT), (bf16_t*)(ws + A_KVLAT), gates, (float*)(ws + A_KR), args.in[4]};
        pg8::gemm_phase<pg8::Epi1, pg8::StaticOrder, true, true>(lds, g, S, E);
    }
    SEAM(1);
    if (IN(2)) {
        const int lane = lane_id();
        const float* gq = args.in[5]; const float* gkv = args.in[7]; const int* pos = (const int*)args.in[1];
        for (int m = gw; m < T; m += NGW) {
            { u32x2* p = (u32x2*)(ws + A_QLAT + (size_t)m * 768 * 2) + lane; u32x2 w[3]; float s = 0.f;
#pragma unroll
              for (int j = 0; j < 3; ++j) { w[j] = p[64 * j]; const float a = bflo(w[j].x), b = bfhi(w[j].x), c = bflo(w[j].y), d = bfhi(w[j].y); s += (a * a + b * b) + (c * c + d * d); }
              const float rstd = 1.0f / sqrtf(wave_sum(s) * (1.0f / 768.0f) + EPS);
#pragma unroll
              for (int j = 0; j < 3; ++j) { const f32x4 gg = *((const f32x4*)gq + lane + 64 * j); u32x2 o; o.x = pk2(bflo(w[j].x) * rstd * gg.x, bfhi(w[j].x) * rstd * gg.y); o.y = pk2(bflo(w[j].y) * rstd * gg.z, bfhi(w[j].y) * rstd * gg.w); p[64 * j] = o; } }
            { u32x2* p = (u32x2*)(ws + A_KVLAT + (size_t)m * 512 * 2) + lane; u32x2 w[2]; float s = 0.f;
#pragma unroll
              for (int j = 0; j < 2; ++j) { w[j] = p[64 * j]; const float a = bflo(w[j].x), b = bfhi(w[j].x), c = bflo(w[j].y), d = bfhi(w[j].y); s += (a * a + b * b) + (c * c + d * d); }
              const float rstd = 1.0f / sqrtf(wave_sum(s) * (1.0f / 512.0f) + EPS);
#pragma unroll
              for (int j = 0; j < 2; ++j) { const f32x4 gg = *((const f32x4*)gkv + lane + 64 * j); u32x2 o; o.x = pk2(bflo(w[j].x) * rstd * gg.x, bfhi(w[j].x) * rstd * gg.y); o.y = pk2(bflo(w[j].y) * rstd * gg.z, bfhi(w[j].y) * rstd * gg.w); p[64 * j] = o; } }
            { const int i = lane & 31; const float ang = (float)pos[m] * args.invf[i];
              double rev = (double)ang * 0.15915494309189535; rev -= floor(rev); const float rf = (float)rev;
              const float sn = __builtin_amdgcn_sinf(rf), cn = __builtin_amdgcn_cosf(rf);
              const float* kr = (const float*)(ws + A_KR) + (size_t)m * 64; const float x1 = kr[i], x2 = kr[i + 32];
              float* cs = (float*)(ws + A_CS) + (size_t)m * 64; bf16_t* ko = (bf16_t*)(ws + A_KROPE) + (size_t)m * 64;
              if (lane < 32) { cs[i] = cn; ko[i] = (bf16_t)f2bf(x1 * cn - x2 * sn); } else { cs[32 + i] = sn; ko[32 + i] = (bf16_t)f2bf(x2 * cn + x1 * sn); } }
        }
    }
    SEAM(2);
    if (IN(3)) {
        { pg8::Gemm g{(const bf16_t*)(ws + A_QLAT), (const bf16_t*)(ws + W_UQ), T, 1536, 768}; pg8::StaticOrder S; S.init(T, 1536, G, bx);
          pg8::EpiQ E{(bf16_t*)(ws + A_Q), (const float*)(ws + A_CS)}; pg8::gemm_phase<pg8::EpiQ, pg8::StaticOrder, true, true>(lds, g, S, E); }
        { pg8::Gemm g{(const bf16_t*)(ws + A_KVLAT), (const bf16_t*)(ws + W_UKV), T, 2048, 512}; pg8::StaticOrder S; S.init(T, 2048, G, bx);
          pg8::EpiKV E{(bf16_t*)(ws + A_KN)}; pg8::gemm_phase<pg8::EpiKV, pg8::StaticOrder, true, true>(lds, g, S, E); }
    }
    SEAM(3);
    if (IN(4)) {
        const int nvc = (G % 16 == 0) ? G / 16 : 0;
        if (nvc) {
            const int bh = vcu / nvc, s = vcu % nvc, npb = 64 / nvc;
            for (int i = npb - 1; i >= 0; --i) { const int pr = (i >> 1) * nvc + s, qb = (i & 1) ? 63 - pr : pr;
                att::attn_unit<true>(lds, bh >> 3, bh & 7, qb, (const bf16_t*)(ws + A_Q), (const bf16_t*)(ws + A_KN), (const bf16_t*)(ws + A_KROPE), (const bf16_t*)(ws + A_VM), (bf16_t*)(ws + A_MLAO)); }
            for (int i = 0; i < npb; ++i) { const int qb = i * nvc + s;
                att::attn_unit<false>(lds, bh >> 3, bh & 7, qb, (const bf16_t*)(ws + A_QSB), (const bf16_t*)(ws + A_KSB), nullptr, (const bf16_t*)(ws + A_VSB), (bf16_t*)(ws + A_SBO)); }
        } else {
            for (int u = bx; u < 1024; u += G) { const int bh = u >> 6, qb = 63 - (u & 63);
                att::attn_unit<true>(lds, bh >> 3, bh & 7, qb, (const bf16_t*)(ws + A_Q), (const bf16_t*)(ws + A_KN), (const bf16_t*)(ws + A_KROPE), (const bf16_t*)(ws + A_VM), (bf16_t*)(ws + A_MLAO));
                att::attn_unit<false>(lds, bh >> 3, bh & 7, qb, (const bf16_t*)(ws + A_QSB), (const bf16_t*)(ws + A_KSB), nullptr, (const bf16_t*)(ws + A_VSB), (bf16_t*)(ws + A_SBO)); }
        }
    }
    SEAM(4);
    if (IN(5)) {
        { pg8::Gemm g{(const bf16_t*)(ws + A_SBO), (const bf16_t*)(ws + W_OSB), T, 2048, 1024}; pg8::StaticOrder S; S.init(T, 2048, G, bx);
          pg8::EpiGate<false> E{gates, (bf16_t*)(ws + A_TMP), U}; pg8::gemm_phase<pg8::EpiGate<false>, pg8::StaticOrder, true, true>(lds, g, S, E); }
    }
    SEAM(5);
    if (IN(6)) {
        { pg8::Gemm g{(const bf16_t*)(ws + A_MLAO), (const bf16_t*)(ws + W_OMLA), T, 2048, 1024}; pg8::StaticOrder S; S.init(T, 2048, G, bx);
          pg8::EpiGate<true> E{gates, (bf16_t*)(ws + A_TMP), U}; pg8::gemm_phase<pg8::EpiGate<true>, pg8::StaticOrder, true, true>(lds, g, S, E); }
    }
    SEAM(6);
    if (IN(7)) {
        pg8::Gemm g{U, (const bf16_t*)(ws + W_OUT), T, 2048, 2048}; pg8::StaticOrder S; S.init(T, 2048, G, bx);
        pg8::EpiPlain E{(bf16_t*)(ws + A_MIXED), 2048}; pg8::gemm_phase<pg8::EpiPlain, pg8::StaticOrder, true, true>(lds, g, S, E);
    }
    SEAM(7);
    if (IN(8)) {
        const int lane = lane_id();
        const float* g1 = args.in[12]; const float* g2 = args.in[13];
        for (int m = gw; m < T; m += NGW) {
            const u32x4* mp = (const u32x4*)(ws + A_MIXED + (size_t)m * DM * 2) + lane; const f32x4* xr = (const f32x4*)(args.in[0] + (size_t)m * DM);
            float v[32]; float s = 0.f;
#pragma unroll
            for (int j = 0; j < 4; ++j) { const u32x4 w = mp[64 * j]; v[8 * j] = bflo(w.x); v[8 * j + 1] = bfhi(w.x); v[8 * j + 2] = bflo(w.y); v[8 * j + 3] = bfhi(w.y); v[8 * j + 4] = bflo(w.z); v[8 * j + 5] = bfhi(w.z); v[8 * j + 6] = bflo(w.w); v[8 * j + 7] = bfhi(w.w); }
#pragma unroll
            for (int e = 0; e < 32; ++e) s += v[e] * v[e];
            const float rstd = 1.0f / sqrtf(wave_sum(s) * (1.0f / DM) + EPS); float s2 = 0.f;
#pragma unroll
            for (int j = 0; j < 4; ++j)
#pragma unroll
                for (int q = 0; q < 2; ++q) { const int c4 = (lane + 64 * j) * 2 + q; const f32x4 xx = xr[c4], gg = ((const f32x4*)g1)[c4]; f32x4 hh;
                    hh.x = xx.x + v[8 * j + 4 * q] * rstd * gg.x; hh.y = xx.y + v[8 * j + 4 * q + 1] * rstd * gg.y; hh.z = xx.z + v[8 * j + 4 * q + 2] * rstd * gg.z; hh.w = xx.w + v[8 * j + 4 * q + 3] * rstd * gg.w;
                    ((f32x4*)(h1 + (size_t)m * DM))[c4] = hh; v[8 * j + 4 * q] = hh.x; v[8 * j + 4 * q + 1] = hh.y; v[8 * j + 4 * q + 2] = hh.z; v[8 * j + 4 * q + 3] = hh.w;
                    s2 += (hh.x * hh.x + hh.y * hh.y) + (hh.z * hh.z + hh.w * hh.w); }
            const float rstd2 = 1.0f / sqrtf(wave_sum(s2) * (1.0f / DM) + EPS);
            u32x4* up = (u32x4*)(U + (size_t)m * DM) + lane;
#pragma unroll
            for (int j = 0; j < 4; ++j) { const int c4 = (lane + 64 * j) * 2; const f32x4 ga = ((const f32x4*)g2)[c4], gb = ((const f32x4*)g2)[c4 + 1]; u32x4 w;
                w.x = pk2(v[8 * j] * rstd2 * ga.x, v[8 * j + 1] * rstd2 * ga.y); w.y = pk2(v[8 * j + 2] * rstd2 * ga.z, v[8 * j + 3] * rstd2 * ga.w);
                w.z = pk2(v[8 * j + 4] * rstd2 * gb.x, v[8 * j + 5] * rstd2 * gb.y); w.w = pk2(v[8 * j + 6] * rstd2 * gb.z, v[8 * j + 7] * rstd2 * gb.w); up[64 * j] = w; }
        }
    }
    SEAM(8);
    if (IN(9)) {
        pg8::Gemm g{U, (const bf16_t*)(ws + W_GU), T, 2 * DFF, 2048}; pg8::StaticOrder S; S.init(T, 2 * DFF, G, bx);
        pg8::EpiSwiglu E{(bf16_t*)(ws + A_ACT)}; pg8::gemm_phase<pg8::EpiSwiglu, pg8::StaticOrder, true, true>(lds, g, S, E);
    }
    SEAM(9);
    if (IN(10)) {
        pg8::Gemm g{(const bf16_t*)(ws + A_ACT), (const bf16_t*)(ws + W_DN), T, 2048, DFF}; pg8::StaticOrder S; S.init(T, 2048, G, bx);
        pg8::EpiPlain E{U, 2048}; pg8::gemm_phase<pg8::EpiPlain, pg8::StaticOrder, true, true>(lds, g, S, E);
    }
    SEAM(10);
    if (IN(11)) {
        const int lane = lane_id();
        const float* g3 = args.in[16];
        for (int m = gw; m < T; m += NGW) {
            const u32x4* mp = (const u32x4*)(U + (size_t)m * DM) + lane;
            float v[32]; float s = 0.f;
#pragma unroll
            for (int j = 0; j < 4; ++j) { const u32x4 w = mp[64 * j]; v[8 * j] = bflo(w.x); v[8 * j + 1] = bfhi(w.x); v[8 * j + 2] = bflo(w.y); v[8 * j + 3] = bfhi(w.y); v[8 * j + 4] = bflo(w.z); v[8 * j + 5] = bfhi(w.z); v[8 * j + 6] = bflo(w.w); v[8 * j + 7] = bfhi(w.w); }
#pragma unroll
            for (int e = 0; e < 32; ++e) s += v[e] * v[e];
            const float rstd = 1.0f / sqrtf(wave_sum(s) * (1.0f / DM) + EPS);
            const f32x4* hr = (const f32x4*)(h1 + (size_t)m * DM);
#pragma unroll
            for (int j = 0; j < 4; ++j)
#pragma unroll
                for (int q = 0; q < 2; ++q) { const int c4 = (lane + 64 * j) * 2 + q; const f32x4 xx = hr[c4], gg = ((const f32x4*)g3)[c4]; f32x4 hh;
                    hh.x = xx.x + v[8 * j + 4 * q] * rstd * gg.x; hh.y = xx.y + v[8 * j + 4 * q + 1] * rstd * gg.y; hh.z = xx.z + v[8 * j + 4 * q + 2] * rstd * gg.z; hh.w = xx.w + v[8 * j + 4 * q + 3] * rstd * gg.w;
                    ((f32x4*)(args.out + (size_t)m * DM))[c4] = hh; }
        }
    }
#undef IN
#undef SEAM
}

extern "C" void kernel_launch(void* const* d_in, const int* in_sizes, int n_in, void* d_out, int out_size, void* d_ws, size_t ws_size, hipStream_t stream) {
    static int grid = 0;
    if (grid == 0) {
        if (n_in != 17 || out_size != T * DM || ws_size < WS_NEED) { fprintf(stderr, "kernel_launch: unexpected shapes (n_in %d out %d ws %zu)\n", n_in, out_size, ws_size); grid = -1; return; }
        int dev = 0, cus = 0, per_cu = 0;
        hipGetDevice(&dev); hipDeviceGetAttribute(&cus, hipDeviceAttributeMultiprocessorCount, dev);
        hipFuncSetAttribute((const void*)mk_fwd, hipFuncAttributeMaxDynamicSharedMemorySize, LDS_BYTES);
        hipOccupancyMaxActiveBlocksPerMultiprocessor(&per_cu, (const void*)mk_fwd, 512, LDS_BYTES);
        (void)hipGetLastError();
        if (per_cu < 1) per_cu = 1;
        grid = cus;
    }
    if (grid < 0) return;
#ifdef EXP_MEMSET_OUT
    (void)hipMemsetAsync(d_out, 0, (size_t)out_size * 4, stream);
#endif
#ifdef EXP_MEMSET_ALL
    (void)hipMemsetAsync(d_ws, 0xAA, WS_NEED, stream);
#endif
#ifdef EXP_MEMSET_QKV
    (void)hipMemsetAsync((char*)d_ws + A_QSB, 0, (size_t)192 * MiB, stream);
#endif
    Args a{};
    for (int i = 0; i < 17; ++i) a.in[i] = (const float*)d_in[i];
    a.out = (float*)d_out; a.ws = (unsigned char*)d_ws;
    for (int i = 0; i < 32; ++i) a.invf[i] = (float)pow(10000.0, -(double)i / 32.0);
#if MK_COOP
    a.ph_lo = 0; a.ph_hi = NPH;
    void* kargs[] = {&a};
    hipError_t e = hipLaunchCooperativeKernel((const void*)mk_fwd, dim3(grid), dim3(512), kargs, LDS_BYTES, stream);
    if (e != hipSuccess) fprintf(stderr, "cooperative launch failed: %s (grid %d)\n", hipGetErrorString(e), grid);
#else
    for (int p = 0; p < NPH; ++p) { a.ph_lo = p; a.ph_hi = p + 1; hipLaunchKernelGGL(mk_fwd, dim3(grid), dim3(512), LDS_BYTES, stream, a); }
#endif
}
```

```cpp
#include <hip/hip_runtime.h>
#include <cstdio>
#include <cstdint>
#include <cmath>
namespace pg8 {
#define PG8_LAS __attribute__((address_space(3)))
typedef unsigned short bf16_t;
typedef short bf16x8 __attribute__((ext_vector_type(8)));
typedef float f32x4 __attribute__((ext_vector_type(4)));
typedef unsigned u32x4 __attribute__((ext_vector_type(4)));
constexpr int BM = 256, BK = 64, HALF = 128, HTB = HALF * BK * 2  , STAGE_BYTES = 8 * HTB, NXCD = 8, WGM = 8;

__host__ __device__ __forceinline__ int lds_byte(int r, int c) { const int st = (r >> 4) * 2 + (c >> 5), rr = r & 15, cc = c & 31, ob = rr * 64 + cc * 2; return st * 1024 + (ob ^ (((ob >> 9) & 1) << 5)); }
__host__ __device__ __forceinline__ void stage_rc(int b, int& R, int& C) { const int st = b / 1024, sb = b % 1024, swz = sb ^ (((sb >> 9) & 1) << 5); R = (st >> 1) * 16 + swz / 64; C = (st & 1) * 32 + (swz % 64) / 2; }
__host__ __device__ __forceinline__ int perm32(int rho) { const int n = rho >> 4, i = rho & 15; return 8 * (i >> 2) + 4 * n + (i & 3); }

struct Unit { int pm, pn; };
struct Gemm { const bf16_t* A; const bf16_t* Bt; int M, N, K; };

struct StaticOrder {
    int nM, nN, nwg, G, c;
    __host__ __device__ void init(int M, int N, int G_, int c_) { nM = M / BM; nN = N / BM; nwg = nM * nN; G = G_; c = c_; }
    __host__ __device__ bool next(int i, Unit& u) const {
        const long L = (long)i * G + c; if (L >= nwg) return false;
        int wgid = (int)L; { const int q = nwg / NXCD, r = nwg % NXCD, xcd = wgid % NXCD, off = wgid / NXCD; wgid = (xcd < r ? xcd * (q + 1) : r * (q + 1) + (xcd - r) * q) + off; }
        const int nig = WGM * nN, gid = wgid / nig, fm = gid * WGM, gsz = (nM - fm) < WGM ? (nM - fm) : WGM;
        u.pm = fm + ((wgid % nig) % gsz); u.pn = (wgid % nig) / gsz; return true;
    }
    __device__ __forceinline__ void a_ready(const Unit&) const {}
    __device__ __forceinline__ void done(const Unit&) const {}
};

__device__ __forceinline__ unsigned cvt_pk_bf16(float lo, float hi) { typedef float f2_ __attribute__((ext_vector_type(2))); typedef __bf16 b2_ __attribute__((ext_vector_type(2))); f2_ v = {lo, hi}; b2_ b = __builtin_convertvector(v, b2_); return __builtin_bit_cast(unsigned, b); }
typedef float f32x2 __attribute__((ext_vector_type(2)));
__device__ __forceinline__ f32x2 gelu_pk(f32x2 v) {
    const f32x2 av = __builtin_elementwise_abs(v), d = av * 0.2316418882f + 1.0f;
    f32x2 t; t.x = __builtin_amdgcn_rcpf(d.x); t.y = __builtin_amdgcn_rcpf(d.y);
    f32x2 q = t * 0.5307027145f + (-0.7265760135f); q = q * t + 0.7107068705f; q = q * t + (-0.142248368f); q = q * t + 0.127414796f; q = q * t;
    const f32x2 s = (v * v) * (-0.72134752044f);
    f32x2 e; e.x = __builtin_amdgcn_exp2f(s.x); e.y = __builtin_amdgcn_exp2f(s.y);
    const f32x2 m = v * (q * e), r = v - m;
    f32x2 o; o.x = v.x < 0.f ? m.x : r.x; o.y = v.y < 0.f ? m.y : r.y; return o;
}

template <class Epi, class Sched, bool ALIGN_EPI = false, bool SP2 = false>
__device__ __forceinline__ void gemm_phase(PG8_LAS unsigned char* lds, const Gemm g, const Sched& S, const Epi& E) {
    const int tid = threadIdx.x, wid = __builtin_amdgcn_readfirstlane(tid >> 6), lane = tid & 63, wr = wid >> 2, wc = wid & 3, fr = lane & 15, fq = lane >> 4;
    const int K = g.K, nt = K / BK;
    unsigned voffA[2], voffB[2];
#pragma unroll
    for (int i = 0; i < 2; ++i) { int R, C; stage_rc(tid * 16 + i * 8192, R, C); const int Rb = Epi::PERM ? ((R & ~31) + perm32(R & 31)) : R;
        voffA[i] = (unsigned)(R * K + C) * 2u; voffB[i] = (unsigned)(Rb * K + C) * 2u; }
    const size_t kstep = (size_t)(BK * 2);
    const size_t hstep = (size_t)HALF * K * 2;
    const size_t tstep = 2 * hstep;
    const unsigned ldsw = (unsigned)wid * 1024u;
    const int aoff = lds_byte(wr * 64 + fr, fq * 8), boff = lds_byte(wc * 32 + fr, fq * 8);
#define PG8_SA(b, h) (((b) * 2 + (h)) * HTB)
#define PG8_SB(b, h) ((4 + (b) * 2 + (h)) * HTB)
#define PG8_STAGE(bufoff, gbase, voff) do { _Pragma("unroll") for (int _i = 0; _i < 2; ++_i) \
        __builtin_amdgcn_global_load_lds((const unsigned*)((const char*)(gbase) + (voff)[_i]), (PG8_LAS unsigned*)(lds + (bufoff) + ldsw + _i * 8192), 16, 0, 0); } while (0)
#define PG8_LDA(dst, b, h) do { _Pragma("unroll") for (int m = 0; m < 4; ++m) _Pragma("unroll") for (int k = 0; k < 2; ++k) dst[m][k] = *(const PG8_LAS bf16x8*)(lds + PG8_SA(b, h) + aoff + m * 2048 + k * 1024); } while (0)
#define PG8_LDB(dst, b, h) do { _Pragma("unroll") for (int n = 0; n < 2; ++n) _Pragma("unroll") for (int k = 0; k < 2; ++k) dst[n][k] = *(const PG8_LAS bf16x8*)(lds + PG8_SB(b, h) + boff + n * 2048 + k * 1024); } while (0)
#define PG8_MMA(ai, bj, At, Bt) do { __builtin_amdgcn_s_setprio(1); _Pragma("unroll") for (int m = 0; m < 4; ++m) _Pragma("unroll") for (int n = 0; n < 2; ++n) _Pragma("unroll") for (int k = 0; k < 2; ++k) \
        acc[ai][bj][m][n] = __builtin_amdgcn_mfma_f32_16x16x32_bf16(Bt[n][k], At[m][k], acc[ai][bj][m][n], 0, 0, 0); __builtin_amdgcn_s_setprio(0); } while (0)
#define PG8_WAIT_V(n) asm volatile("s_waitcnt vmcnt(" #n ")" ::: "memory")
#define PG8_WAIT_L(n) asm volatile("s_waitcnt lgkmcnt(" #n ")" ::: "memory")
#define PG8_BAR __builtin_amdgcn_s_barrier()
#define PG8_SCHED __builtin_amdgcn_sched_barrier(0)
    Unit cur, nxt; int ui = 0;
    if (!S.next(0, cur)) return;
    f32x4 acc[2][2][4][2];
#pragma unroll
    for (int a = 0; a < 2; ++a)
#pragma unroll
        for (int b = 0; b < 2; ++b)
#pragma unroll
            for (int m = 0; m < 4; ++m)
#pragma unroll
                for (int n = 0; n < 2; ++n) acc[a][b][m][n] = (f32x4){0.f, 0.f, 0.f, 0.f};
    bf16x8 At[4][2], B0[2][2], B1[2][2];
    const char* cA = (const char*)g.A + (size_t)cur.pm * tstep; const char* cB = (const char*)g.Bt + (size_t)cur.pn * tstep;
    S.a_ready(cur);
    if constexpr (SP2) {
        PG8_STAGE(PG8_SB(0, 0), cB, voffB); PG8_STAGE(PG8_SB(0, 1), cB + hstep, voffB); PG8_STAGE(PG8_SA(0, 0), cA, voffA); PG8_STAGE(PG8_SA(0, 1), cA + hstep, voffA);
        if (wr == 1) PG8_BAR;
        PG8_WAIT_V(2); PG8_BAR;
        PG8_STAGE(PG8_SB(1, 0), cB + kstep, voffB); PG8_STAGE(PG8_SA(1, 0), cA + kstep, voffA); PG8_STAGE(PG8_SB(1, 1), cB + hstep + kstep, voffB);
        PG8_WAIT_V(6); PG8_BAR;
    } else {
        PG8_STAGE(PG8_SB(0, 0), cB, voffB); PG8_STAGE(PG8_SA(0, 0), cA, voffA); PG8_STAGE(PG8_SB(0, 1), cB + hstep, voffB); PG8_STAGE(PG8_SA(0, 1), cA + hstep, voffA);
        if (wr == 1) PG8_BAR;
        PG8_WAIT_V(4); PG8_BAR;
        PG8_STAGE(PG8_SB(1, 0), cB + kstep, voffB); PG8_STAGE(PG8_SA(1, 0), cA + kstep, voffA); PG8_STAGE(PG8_SB(1, 1), cB + hstep + kstep, voffB);
        PG8_WAIT_V(6); PG8_BAR;
    }
    for (;;) {
        const bool has_next = S.next(ui + 1, nxt);
        const char* nA = has_next ? (const char*)g.A + (size_t)nxt.pm * tstep : cA; const char* nB = has_next ? (const char*)g.Bt + (size_t)nxt.pn * tstep : cB;
        for (int t = 0; t < nt; t += 2) {
            const bool last = (t == nt - 2);
            const char* a1 = cA + (size_t)(t + 1) * kstep;
            const char* a2 = last ? nA : cA + (size_t)(t + 2) * kstep; const char* b2 = last ? nB : cB + (size_t)(t + 2) * kstep;
            const char* a3 = a2 + kstep; const char* b3 = b2 + kstep;
            if (last && has_next) S.a_ready(nxt);
            if constexpr (SP2) {
            PG8_LDB(B0, 0, 0); PG8_LDB(B1, 0, 1); PG8_SCHED; PG8_LDA(At, 0, 0); PG8_STAGE(PG8_SA(1, 1), a1 + hstep, voffA);
            PG8_WAIT_V(8); PG8_WAIT_L(0); PG8_BAR; PG8_MMA(0, 0, At, B0); PG8_MMA(0, 1, At, B1); PG8_BAR; PG8_SCHED;
            PG8_LDA(At, 0, 1); PG8_STAGE(PG8_SB(0, 0), b2, voffB); PG8_STAGE(PG8_SB(0, 1), b2 + hstep, voffB); PG8_STAGE(PG8_SA(0, 0), a2, voffA);
            PG8_WAIT_V(8); PG8_WAIT_L(0); PG8_BAR; PG8_MMA(1, 0, At, B0); PG8_MMA(1, 1, At, B1); PG8_BAR; PG8_SCHED;
            PG8_LDB(B0, 1, 0); PG8_LDB(B1, 1, 1); PG8_SCHED; PG8_LDA(At, 1, 0); PG8_STAGE(PG8_SA(0, 1), a2 + hstep, voffA);
            PG8_WAIT_V(8); PG8_WAIT_L(0); PG8_BAR; PG8_MMA(0, 0, At, B0); PG8_MMA(0, 1, At, B1); PG8_BAR; PG8_SCHED;
            PG8_LDA(At, 1, 1); PG8_STAGE(PG8_SB(1, 0), b3, voffB); PG8_STAGE(PG8_SB(1, 1), b3 + hstep, voffB); PG8_STAGE(PG8_SA(1, 0), a3, voffA);
            PG8_WAIT_V(8); PG8_WAIT_L(0); PG8_BAR; PG8_MMA(1, 0, At, B0); PG8_MMA(1, 1, At, B1); PG8_BAR; PG8_SCHED;
            } else {
            PG8_LDB(B0, 0, 0); PG8_SCHED; PG8_LDA(At, 0, 0); PG8_STAGE(PG8_SA(1, 1), a1 + hstep, voffA);
            PG8_WAIT_L(8); PG8_BAR; PG8_WAIT_L(0); PG8_MMA(0, 0, At, B0); PG8_BAR; PG8_SCHED;
            PG8_LDB(B1, 0, 1); PG8_STAGE(PG8_SB(0, 0), b2, voffB);
            PG8_BAR; PG8_WAIT_L(0); PG8_MMA(0, 1, At, B1); PG8_BAR;
            PG8_LDA(At, 0, 1); PG8_STAGE(PG8_SA(0, 0), a2, voffA);
            PG8_BAR; PG8_WAIT_L(0); PG8_MMA(1, 0, At, B0); PG8_BAR; PG8_SCHED;
            PG8_STAGE(PG8_SB(0, 1), b2 + hstep, voffB);
            PG8_WAIT_V(6); PG8_BAR; PG8_MMA(1, 1, At, B1); PG8_BAR;
            PG8_LDB(B0, 1, 0); PG8_SCHED; PG8_LDA(At, 1, 0); PG8_STAGE(PG8_SA(0, 1), a2 + hstep, voffA);
            PG8_WAIT_L(8); PG8_BAR; PG8_WAIT_L(0); PG8_MMA(0, 0, At, B0); PG8_BAR; PG8_SCHED;
            PG8_LDB(B1, 1, 1); PG8_STAGE(PG8_SB(1, 0), b3, voffB);
            PG8_BAR; PG8_WAIT_L(0); PG8_MMA(0, 1, At, B1); PG8_BAR;
            PG8_LDA(At, 1, 1); PG8_STAGE(PG8_SA(1, 0), a3, voffA);
            PG8_BAR; PG8_WAIT_L(0); PG8_MMA(1, 0, At, B0); PG8_BAR; PG8_SCHED;
            PG8_STAGE(PG8_SB(1, 1), b3 + hstep, voffB);
            PG8_WAIT_V(6); PG8_BAR; PG8_MMA(1, 1, At, B1); PG8_BAR;
            }
        }
        if constexpr (ALIGN_EPI) { if (wr == 0) PG8_BAR; }
        if constexpr (!Epi::AFTER_DRAIN) { E(acc, cur, wr, wc, fr, fq); S.done(cur); }
        if (!has_next) break;
#pragma unroll
        for (int a = 0; a < 2; ++a)
#pragma unroll
            for (int b = 0; b < 2; ++b)
#pragma unroll
                for (int m = 0; m < 4; ++m)
#pragma unroll
                    for (int n = 0; n < 2; ++n) acc[a][b][m][n] = (f32x4){0.f, 0.f, 0.f, 0.f};
        cur = nxt; cA = nA; cB = nB; ++ui;
        if constexpr (ALIGN_EPI) { if (wr == 1) PG8_BAR; }
    }
    PG8_WAIT_V(0);
    if constexpr (!ALIGN_EPI) { if (wr == 0) PG8_BAR; }
    PG8_BAR;
    if constexpr (Epi::AFTER_DRAIN) { E.fused(acc, cur, wr, wc, fr, fq, lds, wid, lane); S.done(cur); }
#undef PG8_SA
#undef PG8_SB
#undef PG8_STAGE
#undef PG8_LDA
#undef PG8_LDB
#undef PG8_MMA
#undef PG8_WAIT_V
#undef PG8_WAIT_L
#undef PG8_BAR
#undef PG8_SCHED
}
}
#define LAS __attribute__((address_space(3)))
typedef pg8::bf16_t bf16_t;
typedef short bf16x8 __attribute__((ext_vector_type(8)));
typedef short s16x4 __attribute__((ext_vector_type(4)));
typedef float f32x4 __attribute__((ext_vector_type(4)));
typedef float f32x16 __attribute__((ext_vector_type(16)));
typedef unsigned u32x4 __attribute__((ext_vector_type(4)));
typedef unsigned u32x2 __attribute__((ext_vector_type(2)));

constexpr int BATCH = 2, SEQ = 16384, T = BATCH * SEQ, DM = 2048, DFF = 5632;
constexpr int N1 = 8704;
constexpr float EPS = 1e-6f;
constexpr float LOG2E = 1.4426950408889634f, LN2 = 0.6931471805599453f;
constexpr float SB_SCALE = 0.08838834764831845f;
constexpr float MLA_C2 = 0.07216878364870323f * LOG2E;
constexpr float SB_EXIT = -110.0f;

constexpr size_t MiB = 1u << 20;
constexpr size_t W_IN = 1 * MiB;
constexpr size_t W_UQ = W_IN + (size_t)N1 * 2048 * 2;
constexpr size_t W_UKV = W_UQ + (size_t)1536 * 768 * 2;
constexpr size_t W_OSB = W_UKV + (size_t)2048 * 512 * 2;
constexpr size_t W_OMLA = W_OSB + (size_t)2048 * 1024 * 2;
constexpr size_t W_OUT = W_OMLA + (size_t)2048 * 1024 * 2;
constexpr size_t W_GU = W_OUT + (size_t)2048 * 2048 * 2;
constexpr size_t W_DN = W_GU + (size_t)11264 * 2048 * 2;
constexpr size_t W_END = W_DN + (size_t)2048 * 5632 * 2;
static_assert(W_END <= 122 * MiB, "weights region");
constexpr size_t A_U = 122 * MiB;
constexpr size_t A_QSB = 250 * MiB;
constexpr size_t A_KSB = 314 * MiB;
constexpr size_t A_VSB = 378 * MiB;
constexpr size_t A_TMP = A_KSB;
constexpr size_t A_QLAT = 442 * MiB;
constexpr size_t A_KVLAT = 490 * MiB;
constexpr size_t A_MLAO = A_QLAT;
constexpr size_t A_KR = 522 * MiB;
constexpr size_t A_KROPE = 530 * MiB;
constexpr size_t A_CS = 534 * MiB;
constexpr size_t A_Q = 542 * MiB;
constexpr size_t A_KN = 638 * MiB;
constexpr size_t A_VM = 702 * MiB;
constexpr size_t A_MIXED = A_Q;
constexpr size_t A_ACT = 250 * MiB;
constexpr size_t A_SBO = A_U;
constexpr size_t A_GATES = 766 * MiB;
constexpr size_t WS_NEED = 1022 * MiB;
static_assert(A_KSB - A_QSB == (size_t)T * 2048 && A_VSB - A_KSB == (size_t)T * 2048 && A_VM - A_KN == (size_t)T * 2048, "contiguous q/k/v");
static_assert(A_ACT + (size_t)T * DFF * 2 <= WS_NEED && A_VM + (size_t)T * 1024 * 2 <= WS_NEED, "ws map");

constexpr int LDS_BYTES = 147456;
constexpr int XB_LDS_OFF = 139264;
constexpr int XB_WS_WORD = 4096;

__device__ __forceinline__ unsigned f2bf(float f) { unsigned u = __builtin_bit_cast(unsigned, f); return (u + 0x7fffu + ((u >> 16) & 1u)) >> 16; }
__device__ __forceinline__ unsigned pk2(float lo, float hi) { return f2bf(lo) | (f2bf(hi) << 16); }
__device__ __forceinline__ float bflo(unsigned w) { return __builtin_bit_cast(float, w << 16); }
__device__ __forceinline__ float bfhi(unsigned w) { return __builtin_bit_cast(float, w & 0xffff0000u); }
__device__ __forceinline__ float ex2(float x) { return __builtin_amdgcn_exp2f(x); }
__device__ __forceinline__ float sigmoidf_(float x) { return __builtin_amdgcn_rcpf(1.0f + ex2(-x * LOG2E)); }
__device__ __forceinline__ int lane_id() { int l; asm volatile("v_mbcnt_lo_u32_b32 %0, -1, 0\n\tv_mbcnt_hi_u32_b32 %0, -1, %0" : "=v"(l)); return l; }
__device__ __forceinline__ float wave_sum(float v) {
#pragma unroll
    for (int o = 1; o < 64; o <<= 1) v += __shfl_xor(v, o);
    return v;
}

namespace pg8 {
typedef const f32x4 (&AccRef)[2][2][4][2];
__device__ __forceinline__ void store_tile_bf16(AccRef acc, bf16_t* base, int ld, int rowb, int c0, float sc) {
#pragma unroll
    for (int ai = 0; ai < 2; ++ai)
#pragma unroll
        for (int m = 0; m < 4; ++m) { bf16_t* rowp = base + (size_t)(rowb + ai * HALF + m * 16) * ld + c0;
#pragma unroll
            for (int bj = 0; bj < 2; ++bj) { const f32x4 v0 = acc[ai][bj][m][0] * sc, v1 = acc[ai][bj][m][1] * sc; u32x4 w;
                w.x = cvt_pk_bf16(v0[0], v0[1]); w.y = cvt_pk_bf16(v0[2], v0[3]); w.z = cvt_pk_bf16(v1[0], v1[1]); w.w = cvt_pk_bf16(v1[2], v1[3]);
                *(u32x4*)(rowp + bj * HALF) = w; } }
}
struct Epi1 {
    static constexpr bool PERM = true, AFTER_DRAIN = false;
    bf16_t *qkv  , *qlat, *kvlat, *gates; float* kr; const float* bgate;
    __device__ __forceinline__ void operator()(AccRef acc, const Unit& u, int wr, int wc, int fr, int fq) const {
        const int pn = u.pn, rowb = u.pm * BM + wr * 64 + fr, cw = wc * 32 + 8 * fq;
        if (pn < 12) { bf16_t* base = qkv + (size_t)(pn >> 2) * ((size_t)T * 1024); store_tile_bf16(acc, base, 1024, rowb, (pn & 3) * 256 + cw, pn < 4 ? SB_SCALE : 1.0f); }
        else if (pn < 15) store_tile_bf16(acc, qlat, 768, rowb, (pn - 12) * 256 + cw, 1.0f);
        else if (pn < 17) store_tile_bf16(acc, kvlat, 512, rowb, (pn - 15) * 256 + cw, 1.0f);
        else if (pn < 33) {
            const int c0 = (pn - 17) * 256 + cw;
            f32x4 bv[2][2];
#pragma unroll
            for (int bj = 0; bj < 2; ++bj)
#pragma unroll
                for (int n = 0; n < 2; ++n) bv[bj][n] = *(const f32x4*)(bgate + c0 + bj * HALF + 4 * n);
#pragma unroll
            for (int ai = 0; ai < 2; ++ai)
#pragma unroll
                for (int m = 0; m < 4; ++m) { bf16_t* rowp = gates + (size_t)(rowb + ai * HALF + m * 16) * 4096 + c0;
#pragma unroll
                    for (int bj = 0; bj < 2; ++bj) { const f32x4 v0 = acc[ai][bj][m][0] + bv[bj][0], v1 = acc[ai][bj][m][1] + bv[bj][1]; u32x4 w;
                        w.x = cvt_pk_bf16(sigmoidf_(v0[0]), sigmoidf_(v0[1])); w.y = cvt_pk_bf16(sigmoidf_(v0[2]), sigmoidf_(v0[3]));
                        w.z = cvt_pk_bf16(sigmoidf_(v1[0]), sigmoidf_(v1[1])); w.w = cvt_pk_bf16(sigmoidf_(v1[2]), sigmoidf_(v1[3]));
                        *(u32x4*)(rowp + bj * HALF) = w; } }
        } else if (wc < 2) {
#pragma unroll
            for (int ai = 0; ai < 2; ++ai)
#pragma unroll
                for (int m = 0; m < 4; ++m) { float* rowp = kr + (size_t)(rowb + ai * HALF + m * 16) * 64 + cw;
                    *(f32x4*)rowp = acc[ai][0][m][0]; *(f32x4*)(rowp + 4) = acc[ai][0][m][1]; }
        }
    }
};
struct EpiQ {
    static constexpr bool PERM = true, AFTER_DRAIN = false;
    bf16_t* q; const float* cs;
    __device__ __forceinline__ void operator()(AccRef acc, const Unit& u, int wr, int wc, int fr, int fq) const {
        const int pn = u.pn, rowb = u.pm * BM + wr * 64 + fr, cw = wc * 32 + 8 * fq;
        if (pn < 4) {
#pragma unroll
            for (int ai = 0; ai < 2; ++ai)
#pragma unroll
                for (int m = 0; m < 4; ++m) { bf16_t* rowp = q + (size_t)(rowb + ai * HALF + m * 16) * 1536 + cw;
#pragma unroll
                    for (int bj = 0; bj < 2; ++bj) { const f32x4 v0 = acc[ai][bj][m][0] * MLA_C2, v1 = acc[ai][bj][m][1] * MLA_C2; u32x4 w;
                        w.x = cvt_pk_bf16(v0[0], v0[1]); w.y = cvt_pk_bf16(v0[2], v0[3]); w.z = cvt_pk_bf16(v1[0], v1[1]); w.w = cvt_pk_bf16(v1[2], v1[3]);
                        *(u32x4*)(rowp + (2 * pn + bj) * 192) = w; } }
        } else {
            const int head = (pn - 4) * 4 + wc, i0 = 8 * fq;
#pragma unroll
            for (int ai = 0; ai < 2; ++ai)
#pragma unroll
                for (int m = 0; m < 4; ++m) { const int row = rowb + ai * HALF + m * 16; const float* cp = cs + (size_t)row * 64 + i0;
                    const f32x4 c0 = *(const f32x4*)cp, c1 = *(const f32x4*)(cp + 4), s0 = *(const f32x4*)(cp + 32), s1 = *(const f32x4*)(cp + 36);
                    const f32x4 a0 = acc[ai][0][m][0], a1 = acc[ai][0][m][1], b0 = acc[ai][1][m][0], b1 = acc[ai][1][m][1];
                    const f32x4 o10 = (a0 * c0 - b0 * s0) * MLA_C2, o11 = (a1 * c1 - b1 * s1) * MLA_C2, o20 = (b0 * c0 + a0 * s0) * MLA_C2, o21 = (b1 * c1 + a1 * s1) * MLA_C2;
                    bf16_t* rowp = q + (size_t)row * 1536 + head * 192 + 128 + i0; u32x4 w;
                    w.x = cvt_pk_bf16(o10[0], o10[1]); w.y = cvt_pk_bf16(o10[2], o10[3]); w.z = cvt_pk_bf16(o11[0], o11[1]); w.w = cvt_pk_bf16(o11[2], o11[3]);
                    *(u32x4*)rowp = w;
                    w.x = cvt_pk_bf16(o20[0], o20[1]); w.y = cvt_pk_bf16(o20[2], o20[3]); w.z = cvt_pk_bf16(o21[0], o21[1]); w.w = cvt_pk_bf16(o21[2], o21[3]);
                    *(u32x4*)(rowp + 32) = w; }
        }
    }
};
struct EpiKV {
    static constexpr bool PERM = true, AFTER_DRAIN = false;
    bf16_t* kv;
    __device__ __forceinline__ void operator()(AccRef acc, const Unit& u, int wr, int wc, int fr, int fq) const {
        const int pn = u.pn; store_tile_bf16(acc, kv + (size_t)(pn >> 2) * ((size_t)T * 1024), 1024, u.pm * BM + wr * 64 + fr, (pn & 3) * 256 + wc * 32 + 8 * fq, 1.0f);
    }
};
struct EpiPlain {
    static constexpr bool PERM = true, AFTER_DRAIN = false;
    bf16_t* o; int ld;
    __device__ __forceinline__ void operator()(AccRef acc, const Unit& u, int wr, int wc, int fr, int fq) const {
        store_tile_bf16(acc, o, ld, u.pm * BM + wr * 64 + fr, u.pn * 256 + wc * 32 + 8 * fq, 1.0f);
    }
};
template <bool SECOND> struct EpiGate {
    static constexpr bool PERM = true, AFTER_DRAIN = false;
    const bf16_t* gates; bf16_t* tmp; bf16_t* out;
    __device__ __forceinline__ void operator()(AccRef acc, const Unit& u, int wr, int wc, int fr, int fq) const {
        const int rowb = u.pm * BM + wr * 64 + fr, c0 = u.pn * 256 + wc * 32 + 8 * fq;
#pragma unroll
        for (int ai = 0; ai < 2; ++ai)
#pragma unroll
            for (int m = 0; m < 4; ++m) { const size_t row = (size_t)(rowb + ai * HALF + m * 16);
#pragma unroll
                for (int bj = 0; bj < 2; ++bj) { const int c = c0 + bj * HALF;
                    const u32x4 g = *(const u32x4*)(gates + row * 4096 + (SECOND ? 2048 : 0) + c);
                    const f32x4 a0 = acc[ai][bj][m][0], a1 = acc[ai][bj][m][1];
                    float r[8] = {a0[0] * bflo(g.x), a0[1] * bfhi(g.x), a0[2] * bflo(g.y), a0[3] * bfhi(g.y), a1[0] * bflo(g.z), a1[1] * bfhi(g.z), a1[2] * bflo(g.w), a1[3] * bfhi(g.w)};
                    if (SECOND) { const u32x4 t = *(const u32x4*)(tmp + row * 2048 + c);
                        r[0] += bflo(t.x); r[1] += bfhi(t.x); r[2] += bflo(t.y); r[3] += bfhi(t.y); r[4] += bflo(t.z); r[5] += bfhi(t.z); r[6] += bflo(t.w); r[7] += bfhi(t.w); }
                    u32x4 w; w.x = cvt_pk_bf16(r[0], r[1]); w.y = cvt_pk_bf16(r[2], r[3]); w.z = cvt_pk_bf16(r[4], r[5]); w.w = cvt_pk_bf16(r[6], r[7]);
                    *(u32x4*)((SECOND ? out : tmp) + row * 2048 + c) = w; } }
    }
};
struct EpiSwiglu {
    static constexpr bool PERM = true, AFTER_DRAIN = false;
    bf16_t* act;
    __device__ __forceinline__ void operator()(AccRef acc, const Unit& u, int wr, int wc, int fr, int fq) const {
        const int rowb = u.pm * BM + wr * 64 + fr, c0 = u.pn * 128 + wc * 32 + 8 * fq;
#pragma unroll
        for (int ai = 0; ai < 2; ++ai)
#pragma unroll
            for (int m = 0; m < 4; ++m) { const f32x4 g0 = acc[ai][0][m][0], g1 = acc[ai][0][m][1], u0 = acc[ai][1][m][0], u1 = acc[ai][1][m][1]; float r[8];
#pragma unroll
                for (int k = 0; k < 4; ++k) { r[k] = g0[k] * sigmoidf_(g0[k]) * u0[k]; r[4 + k] = g1[k] * sigmoidf_(g1[k]) * u1[k]; }
                u32x4 w; w.x = cvt_pk_bf16(r[0], r[1]); w.y = cvt_pk_bf16(r[2], r[3]); w.z = cvt_pk_bf16(r[4], r[5]); w.w = cvt_pk_bf16(r[6], r[7]);
                *(u32x4*)(act + (size_t)(rowb + ai * HALF + m * 16) * DFF + c0) = w; }
    }
};
}

namespace att {
constexpr int VSTR = 320, VOFF = 64 * 400, STAGE = VOFF + 64 * VSTR  , FLAG_OFF = 2 * STAGE;
typedef short v4i16_t __attribute__((ext_vector_type(4)));
__device__ __forceinline__ int crow(int r, int hi) { return (r & 3) + 8 * (r >> 2) + 4 * hi; }
__device__ __forceinline__ unsigned cvtpk(float lo, float hi) { typedef float f2 __attribute__((ext_vector_type(2))); typedef __bf16 b2 __attribute__((ext_vector_type(2))); f2 v = {lo, hi}; b2 b = __builtin_convertvector(v, b2); return __builtin_bit_cast(unsigned, b); }
__device__ __forceinline__ s16x4 vtr(const LAS unsigned char* p) { return __builtin_bit_cast(s16x4, __builtin_amdgcn_ds_read_tr16_b64_v4i16((LAS v4i16_t*)p)); }
__device__ __forceinline__ float partner(float x, int hi) { auto rr = __builtin_amdgcn_permlane32_swap(__float_as_uint(x), __float_as_uint(x), false, false); return __uint_as_float(hi ? rr[0] : rr[1]); }

#ifndef EXP_SKIP_SB
#define EXP_SKIP_SB 0
#endif
template <bool MLA>
__device__ __forceinline__ void attn_unit(LAS unsigned char* lds, const int b, const int h, const int qb,
        const bf16_t* Q, const bf16_t* __restrict__ K, const bf16_t* __restrict__ KR, const bf16_t* __restrict__ V, bf16_t* O) {
    constexpr int DK = MLA ? 192 : 128, NKS = DK / 16, KSTR = DK * 2 + 16, QP = MLA ? 1536 : 1024;
    const int tid = threadIdx.x, lane = tid & 63, r32 = lane & 31, hi = lane >> 5;
    const int wid = __builtin_amdgcn_readfirstlane(tid >> 6);
    const size_t rowbase = (size_t)b * SEQ;
    const int q0 = qb * 256, NT = 4 * qb + 4, tdiag = 4 * qb + (wid >> 1);
    if (!MLA && EXP_SKIP_SB) { bf16_t* orow_ = O + (rowbase + q0 + wid * 32 + r32) * 1024 + h * 128 + 4 * hi;
        for (int dt = 0; dt < 4; ++dt) for (int g = 0; g < 4; ++g) { u32x2 w; w.x = 0x3f803f00u + (unsigned)((r32 + dt + g) & 7) * 0x00010001u; w.y = 0xbf803e80u; *(u32x2*)(orow_ + dt * 32 + 8 * g) = w; }
        return; }
    const int srow = tid >> 4, sch = tid & 15;
    const bf16_t* kg = K + (rowbase + srow) * 1024 + h * 128 + sch * 8;
    const bf16_t* vg = V + (rowbase + srow) * 1024 + h * 128 + sch * 8;
    const bf16_t* rg = KR + (rowbase + (tid >> 3)) * 64 + (tid & 7) * 8;
    const int kdst = srow * KSTR + sch * 16, vdst = VOFF + srow * VSTR + sch * 16, rdst = (tid >> 3) * KSTR + 256 + (tid & 7) * 16;
    u32x4 sk0, sk1, sv0, sv1, sr;
#define ATT_LOAD(tt) do { const size_t o_ = (size_t)(tt) * 65536; sk0 = *(const u32x4*)(kg + o_); sk1 = *(const u32x4*)(kg + o_ + 32768); sv0 = *(const u32x4*)(vg + o_); sv1 = *(const u32x4*)(vg + o_ + 32768); \
        if (MLA) sr = *(const u32x4*)(rg + (size_t)(tt) * 4096); } while (0)
#define ATT_STORE(so) do { *(LAS u32x4*)(lds + (so) + kdst) = sk0; *(LAS u32x4*)(lds + (so) + kdst + 32 * KSTR) = sk1; *(LAS u32x4*)(lds + (so) + vdst) = sv0; *(LAS u32x4*)(lds + (so) + vdst + 32 * VSTR) = sv1; \
        if (MLA) *(LAS u32x4*)(lds + (so) + rdst) = sr; } while (0)
    const int t0 = MLA ? 0 : NT - 1, tstep = MLA ? 1 : -1;
    ATT_LOAD(t0);
    bf16x8 qf[NKS];
    { const bf16_t* qrow = Q + (rowbase + q0 + wid * 32 + r32) * QP + h * DK + hi * 8;
#pragma unroll
      for (int d0 = 0; d0 < NKS; ++d0) qf[d0] = *(const bf16x8*)(qrow + d0 * 16); }
    f32x16 o[4];
#pragma unroll
    for (int i = 0; i < 4; ++i)
#pragma unroll
        for (int r = 0; r < 16; ++r) o[i][r] = 0.f;
    float m_ref = 0.f, lsum = 0.f, R = 0.f;
    const int kfb = r32 * KSTR + hi * 16;
    const int vfb = VOFF + (4 * hi + ((lane & 15) >> 2)) * VSTR + (((lane >> 4) & 1) * 16 + (lane & 3) * 4) * 2;
    volatile LAS unsigned* flags = (volatile LAS unsigned*)(lds + FLAG_OFF);
    ATT_STORE(0);
    if (NT > 1) ATT_LOAD(t0 + tstep);
    __syncthreads();
    int t = t0;
    for (int it = 0; it < NT; ++it, t += tstep) {
        const int st = (it & 1) * STAGE;
        if (it + 1 < NT) ATT_STORE(((it + 1) & 1) * STAGE);
        if (it + 2 < NT) ATT_LOAD(t + 2 * tstep);
        if (MLA) { if (t <= tdiag) {
            f32x16 p0, p1;
#pragma unroll
            for (int r = 0; r < 16; ++r) { p0[r] = -m_ref; p1[r] = -m_ref; }
#pragma unroll
            for (int d0 = 0; d0 < NKS; ++d0) {
                const bf16x8 k0 = *(const LAS bf16x8*)(lds + st + kfb + d0 * 32);
                p0 = __builtin_amdgcn_mfma_f32_32x32x16_bf16(k0, qf[d0], p0, 0, 0, 0);
            }
            float tmA = p0[0];
#pragma unroll
            for (int r = 1; r < 16; ++r) tmA = fmaxf(tmA, p0[r]);
            tmA = fmaxf(tmA, partner(tmA, hi));
            float dA = 0.f; bool flagA = false;
            if (it == 0 || __any(tmA > 8.0f)) {
                dA = (it == 0) ? tmA : fmaxf(tmA, 0.f);
                if (it != 0) { const float sc = ex2(-dA); lsum *= sc;
#pragma unroll
                    for (int i = 0; i < 4; ++i)
#pragma unroll
                        for (int r = 0; r < 16; ++r) o[i][r] *= sc; }
                m_ref += dA; flagA = true;
#pragma unroll
                for (int r = 0; r < 16; ++r) p0[r] -= dA;
            }
#pragma unroll
            for (int d0 = 0; d0 < NKS; ++d0) {
                const bf16x8 k1 = *(const LAS bf16x8*)(lds + st + kfb + 32 * KSTR + d0 * 32);
                p1 = __builtin_amdgcn_mfma_f32_32x32x16_bf16(k1, qf[d0], p1, 0, 0, 0);
            }
            { float ps = 0.f;
#pragma unroll
              for (int r = 0; r < 16; ++r) { p0[r] = ex2(p0[r]); ps += p0[r]; }
              lsum += ps; }
            if (flagA) {
#pragma unroll
                for (int r = 0; r < 16; ++r) p1[r] -= dA;
            }
            float tmB = p1[0];
#pragma unroll
            for (int r = 1; r < 16; ++r) tmB = fmaxf(tmB, p1[r]);
            tmB = fmaxf(tmB, partner(tmB, hi));
            if (__any(tmB > 8.0f)) {
                const float dB = fmaxf(tmB, 0.f), sc = ex2(-dB); lsum *= sc; m_ref += dB;
#pragma unroll
                for (int i = 0; i < 4; ++i)
#pragma unroll
                    for (int r = 0; r < 16; ++r) o[i][r] *= sc;
#pragma unroll
                for (int r = 0; r < 16; ++r) { p0[r] *= sc; p1[r] -= dB; }
            }
            bf16x8 pf[4];
            { u32x4 w;
              w.x = cvtpk(p0[0], p0[1]); w.y = cvtpk(p0[2], p0[3]); w.z = cvtpk(p0[4], p0[5]); w.w = cvtpk(p0[6], p0[7]); pf[0] = __builtin_bit_cast(bf16x8, w);
              w.x = cvtpk(p0[8], p0[9]); w.y = cvtpk(p0[10], p0[11]); w.z = cvtpk(p0[12], p0[13]); w.w = cvtpk(p0[14], p0[15]); pf[1] = __builtin_bit_cast(bf16x8, w); }
#pragma unroll
            for (int s = 0; s < 2; ++s)
#pragma unroll
                for (int dt = 0; dt < 4; ++dt) {
                    const s16x4 lo = vtr(lds + st + vfb + s * 16 * VSTR + dt * 64);
                    const s16x4 hh = vtr(lds + st + vfb + s * 16 * VSTR + dt * 64 + 8 * VSTR);
                    const bf16x8 vf = {lo[0], lo[1], lo[2], lo[3], hh[0], hh[1], hh[2], hh[3]};
                    o[dt] = __builtin_amdgcn_mfma_f32_32x32x16_bf16(vf, pf[s], o[dt], 0, 0, 0);
                }
            { float ps = 0.f;
#pragma unroll
              for (int r = 0; r < 16; ++r) { p1[r] = ex2(p1[r]); ps += p1[r]; }
              lsum += ps;
              u32x4 w;
              w.x = cvtpk(p1[0], p1[1]); w.y = cvtpk(p1[2], p1[3]); w.z = cvtpk(p1[4], p1[5]); w.w = cvtpk(p1[6], p1[7]); pf[2] = __builtin_bit_cast(bf16x8, w);
              w.x = cvtpk(p1[8], p1[9]); w.y = cvtpk(p1[10], p1[11]); w.z = cvtpk(p1[12], p1[13]); w.w = cvtpk(p1[14], p1[15]); pf[3] = __builtin_bit_cast(bf16x8, w); }
#pragma unroll
            for (int s = 2; s < 4; ++s)
#pragma unroll
                for (int dt = 0; dt < 4; ++dt) {
                    const s16x4 lo = vtr(lds + st + vfb + s * 16 * VSTR + dt * 64);
                    const s16x4 hh = vtr(lds + st + vfb + s * 16 * VSTR + dt * 64 + 8 * VSTR);
                    const bf16x8 vf = {lo[0], lo[1], lo[2], lo[3], hh[0], hh[1], hh[2], hh[3]};
                    o[dt] = __builtin_amdgcn_mfma_f32_32x32x16_bf16(vf, pf[s], o[dt], 0, 0, 0);
                }
        } } else
        if (t <= tdiag) {
            f32x16 p0, p1;
#pragma unroll
            for (int r = 0; r < 16; ++r) { p0[r] = 0.f; p1[r] = 0.f; }
#pragma unroll
            for (int d0 = 0; d0 < NKS; ++d0) {
                const bf16x8 k0 = *(const LAS bf16x8*)(lds + st + kfb + d0 * 32);
                const bf16x8 k1 = *(const LAS bf16x8*)(lds + st + kfb + 32 * KSTR + d0 * 32);
                p0 = __builtin_amdgcn_mfma_f32_32x32x16_bf16(k0, qf[d0], p0, 0, 0, 0);
                p1 = __builtin_amdgcn_mfma_f32_32x32x16_bf16(k1, qf[d0], p1, 0, 0, 0);
            }
            if (MLA) {
                float tm = fmaxf(p0[0], p1[0]);
#pragma unroll
                for (int r = 1; r < 16; ++r) tm = fmaxf(tm, fmaxf(p0[r], p1[r]));
                tm = fmaxf(tm, partner(tm, hi));
                if (__any(tm > m_ref + 8.0f)) {
                    const float mn = fmaxf(m_ref, tm), sc = ex2(m_ref - mn);
                    lsum *= sc;
#pragma unroll
                    for (int i = 0; i < 4; ++i)
#pragma unroll
                        for (int r = 0; r < 16; ++r) o[i][r] *= sc;
                    m_ref = mn;
                }
                float ps = 0.f;
#pragma unroll
                for (int r = 0; r < 16; ++r) { p0[r] = ex2(p0[r] - m_ref); p1[r] = ex2(p1[r] - m_ref); ps += p0[r] + p1[r]; }
                lsum += ps;
            } else {
                const bool diag = (t == tdiag);
                const int qrel = (wid & 1) * 32 + r32;
                float lk[32];
#pragma unroll
                for (int x = 0; x < 32; ++x) {
                    const float z = x < 16 ? p0[x] : p1[x - 16];
                    const int kv = (x < 16 ? 0 : 32) + crow(x & 15, hi);
                    const bool valid = !diag || kv < qrel;
                    const float e = ex2(-fabsf(z) * LOG2E);
                    const float sp = fmaxf(z, 0.f) + LN2 * __builtin_amdgcn_logf(1.0f + e);
                    lk[x] = valid ? -sp : 0.f;
                }
                float gs[8], ot[8], ST[8];
#pragma unroll
                for (int k = 0; k < 8; ++k) { gs[k] = (lk[4 * k] + lk[4 * k + 1]) + (lk[4 * k + 2] + lk[4 * k + 3]); ot[k] = partner(gs[k], hi); }
                ST[7] = 0.f;
#pragma unroll
                for (int k = 6; k >= 0; --k) ST[k] = ST[k + 1] + (gs[k + 1] + ot[k + 1]);
                const float tot = ST[0] + (gs[0] + ot[0]);
#pragma unroll
                for (int k = 0; k < 8; ++k) {
                    const float s3 = R + ST[k] + (hi == 0 ? ot[k] : 0.f);
                    const float s2 = s3 + lk[4 * k + 3], s1 = s2 + lk[4 * k + 2], s0 = s1 + lk[4 * k + 1];
                    const float ss[4] = {s0, s1, s2, s3};
#pragma unroll
                    for (int i = 0; i < 4; ++i) {
                        const int x = 4 * k + i;
                        const float z = x < 16 ? p0[x] : p1[x - 16];
                        const int kv = (x < 16 ? 0 : 32) + crow(x & 15, hi);
                        const bool valid = !diag || kv < qrel;
                        const float w = valid ? ex2((z + lk[x] + ss[i]) * LOG2E) : 0.f;
                        if (x < 16) p0[x] = w; else p1[x - 16] = w;
                    }
                }
                R += tot;
            }
            bf16x8 pf[4];
            { u32x4 w;
              w.x = cvtpk(p0[0], p0[1]); w.y = cvtpk(p0[2], p0[3]); w.z = cvtpk(p0[4], p0[5]); w.w = cvtpk(p0[6], p0[7]); pf[0] = __builtin_bit_cast(bf16x8, w);
              w.x = cvtpk(p0[8], p0[9]); w.y = cvtpk(p0[10], p0[11]); w.z = cvtpk(p0[12], p0[13]); w.w = cvtpk(p0[14], p0[15]); pf[1] = __builtin_bit_cast(bf16x8, w);
              w.x = cvtpk(p1[0], p1[1]); w.y = cvtpk(p1[2], p1[3]); w.z = cvtpk(p1[4], p1[5]); w.w = cvtpk(p1[6], p1[7]); pf[2] = __builtin_bit_cast(bf16x8, w);
              w.x = cvtpk(p1[8], p1[9]); w.y = cvtpk(p1[10], p1[11]); w.z = cvtpk(p1[12], p1[13]); w.w = cvtpk(p1[14], p1[15]); pf[3] = __builtin_bit_cast(bf16x8, w); }
#pragma unroll
            for (int s = 0; s < 4; ++s)
#pragma unroll
                for (int dt = 0; dt < 4; ++dt) {
                    const s16x4 lo = vtr(lds + st + vfb + s * 16 * VSTR + dt * 64);
                    const s16x4 hh = vtr(lds + st + vfb + s * 16 * VSTR + dt * 64 + 8 * VSTR);
                    const bf16x8 vf = {lo[0], lo[1], lo[2], lo[3], hh[0], hh[1], hh[2], hh[3]};
                    o[dt] = __builtin_amdgcn_mfma_f32_32x32x16_bf16(vf, pf[s], o[dt], 0, 0, 0);
                }
        }
        if (!MLA) { const bool dn = __all(R <= SB_EXIT); if (lane == 0) flags[(it & 1) * 8 + wid] = dn ? 1u : 0u; }
        __syncthreads();
        if (!MLA) { unsigned a = 1u;
#pragma unroll
            for (int w = 0; w < 8; ++w) a &= flags[(it & 1) * 8 + w];
#ifndef EXP_NO_EXIT
            if (a) break;
#else
            if (a == 12345u) break;
#endif
            }
    }
#undef ATT_LOAD
#undef ATT_STORE
    float inv = 1.0f;
    if (MLA) inv = __builtin_amdgcn_rcpf(lsum + partner(lsum, hi));
    bf16_t* orow = O + (rowbase + q0 + wid * 32 + r32) * 1024 + h * 128 + 4 * hi;
#pragma unroll
    for (int dt = 0; dt < 4; ++dt)
#pragma unroll
        for (int g = 0; g < 4; ++g) { u32x2 w; w.x = cvtpk(o[dt][4 * g] * inv, o[dt][4 * g + 1] * inv); w.y = cvtpk(o[dt][4 * g + 2] * inv, o[dt][4 * g + 3] * inv);
            *(u32x2*)(orow + dt * 32 + 8 * g) = w; }
}
}

#define XB_TMO      128
#define XB_XCNT(j)  (256  + 64 * (j))
#define XB_XSUB(j)  (1280 + 64 * (j))
#define XB_XGEN(j)  (2304 + 64 * (j))
#define XB_TOP      3328
#define XB_TOPGEN   3392
#define XCD_BAR_WORDS 3456
#define XB_SPIN_CAP (1u << 18)

__device__ __forceinline__ unsigned xb_ld(unsigned* p)              { return __hip_atomic_load(p, __ATOMIC_RELAXED, __HIP_MEMORY_SCOPE_AGENT); }
__device__ __forceinline__ unsigned xb_add(unsigned* p, unsigned v) { return __hip_atomic_fetch_add(p, v, __ATOMIC_RELAXED, __HIP_MEMORY_SCOPE_AGENT); }
__device__ __forceinline__ unsigned xb_xcc_id() { return (unsigned)__builtin_amdgcn_s_getreg((3 << 11) | 20) & 0xFu; }
#define XB_SPIN(cond, bar) do { unsigned _sp = 0; while (cond) { __builtin_amdgcn_s_sleep(1); \
    if ((++_sp & 255u) == 0u) { if (xb_ld(&(bar)[XB_TMO])) break; if (_sp > XB_SPIN_CAP) { atomicAdd(&(bar)[XB_TMO], 1u); break; } } } } while (0)

struct XcdBarrier {
    unsigned* bar; unsigned x;
    volatile LAS unsigned* st;
};

__device__ __forceinline__ XcdBarrier xcd_barrier_post(unsigned* bar, volatile LAS unsigned* st) {
    XcdBarrier b; b.bar = bar; b.x = xb_xcc_id(); b.st = st;
    if (threadIdx.x == 0) (void)xb_add(&bar[XB_XCNT(b.x)], 1u);
    return b;
}
__device__ __forceinline__ void xcd_barrier_complete(unsigned* bar, unsigned x, unsigned& nloc, unsigned& nx) {
    const unsigned G = gridDim.x * gridDim.y * gridDim.z;
    unsigned sum, cnt, mine, sp = 0u;
    for (;;) {
        sum = 0u; cnt = 0u; mine = 0u;
#pragma unroll
        for (unsigned j = 0; j < 16; ++j) { const unsigned c = xb_ld(&bar[XB_XCNT(j)]); sum += c; cnt += (c > 0u) ? 1u : 0u; mine = (j == x) ? c : mine; }
        if (sum == G) break;
        __builtin_amdgcn_s_sleep(1);
        if ((++sp & 255u) == 0u) { if (xb_ld(&bar[XB_TMO])) break; if (sp > XB_SPIN_CAP) { atomicAdd(&bar[XB_TMO], 1u); break; } }
    }
    nloc = mine > 0u ? mine : 1u; nx = cnt > 0u ? cnt : 1u;
}

__device__ __forceinline__ void xcd_barrier(const XcdBarrier& b) {
    asm volatile("s_waitcnt vmcnt(0)" ::: "memory");
    __syncthreads();
    if (threadIdx.x == 0) {
        unsigned* bar = b.bar;
        __builtin_amdgcn_s_waitcnt(0);
        unsigned nloc = b.st[0], nx = b.st[1];
        if (nloc == 0u) { xcd_barrier_complete(bar, b.x, nloc, nx); b.st[0] = nloc; b.st[1] = nx; }
        const unsigned old = xb_add(&bar[XB_XSUB(b.x)], 1u);
        const unsigned gen = old / nloc;
        if (old + 1u == (gen + 1u) * nloc) {
            __builtin_amdgcn_fence(__ATOMIC_RELEASE, "agent");
            asm volatile("s_waitcnt vmcnt(0)" ::: "memory");
            const unsigned og = xb_add(&bar[XB_TOP], 1u);
            const unsigned tg = og / nx;
            if (og + 1u == (tg + 1u) * nx) xb_add(&bar[XB_TOPGEN], 1u);
            else XB_SPIN(xb_ld(&bar[XB_TOPGEN]) == tg, bar);
            __builtin_amdgcn_fence(__ATOMIC_ACQUIRE, "agent");
            xb_add(&bar[XB_XGEN(b.x)], 1u);
            asm volatile("s_waitcnt vmcnt(0)" ::: "memory");
        } else {
            XB_SPIN(xb_ld(&bar[XB_XGEN(b.x)]) == gen, bar);
            __builtin_amdgcn_fence(__ATOMIC_ACQUIRE, "agent");
            asm volatile("s_waitcnt vmcnt(0)" ::: "memory");
        }
    }
    __syncthreads();
}


#include <hip/hip_cooperative_groups.h>
namespace cg = cooperative_groups;
#ifndef MK_COOP
#define MK_COOP 1
#endif
constexpr int NPH = 12;
constexpr int RBH = 2;
constexpr int RB = 4;
struct Args { const float* in[17]; float* out; unsigned char* ws; float invf[32]; int ph_lo, ph_hi; };
static_assert(sizeof(Args) == 17 * 8 + 16 + 128 + 8, "Args has no padding");


__device__ __forceinline__ void unpack8(const u32x4 w, float* v) { v[0] = bflo(w.x); v[1] = bfhi(w.x); v[2] = bflo(w.y); v[3] = bfhi(w.y); v[4] = bflo(w.z); v[5] = bfhi(w.z); v[6] = bflo(w.w); v[7] = bfhi(w.w); }
__device__ __forceinline__ void rowU_load(const float* x, int m, int lane, f32x4 (&v)[8]) {
    const f32x4* xr = (const f32x4*)(x + (size_t)m * DM) + lane;
#pragma unroll
    for (int j = 0; j < 8; ++j) v[j] = xr[64 * j];
}
__device__ __forceinline__ void rowU_finish(const f32x4 (&v)[8], const float* g, bf16_t* U, int m, int lane) {
    float s = 0.f;
#pragma unroll
    for (int j = 0; j < 8; ++j) s += (v[j].x * v[j].x + v[j].y * v[j].y) + (v[j].z * v[j].z + v[j].w * v[j].w);
    const float rstd = 1.0f / sqrtf(wave_sum(s) * (1.0f / DM) + EPS);
    u32x2* o8 = (u32x2*)(U + (size_t)m * DM) + lane;
#pragma unroll
    for (int j = 0; j < 8; ++j) { const f32x4 gg = *((const f32x4*)g + lane + 64 * j); u32x2 w; w.x = pk2(v[j].x * rstd * gg.x, v[j].y * rstd * gg.y); w.y = pk2(v[j].z * rstd * gg.z, v[j].w * rstd * gg.w); o8[64 * j] = w; }
}
__device__ __forceinline__ void rowH_load(const bf16_t* mixed, const float* x, int m, int lane, u32x4 (&mw)[4], f32x4 (&xx)[8]) {
    const u32x4* mp = (const u32x4*)(mixed + (size_t)m * DM) + lane; const f32x4* xr = (const f32x4*)(x + (size_t)m * DM);
#pragma unroll
    for (int j = 0; j < 4; ++j) { mw[j] = mp[64 * j]; xx[2 * j] = xr[(lane + 64 * j) * 2]; xx[2 * j + 1] = xr[(lane + 64 * j) * 2 + 1]; }
}
__device__ __forceinline__ void rowH_finish(const u32x4 (&mw)[4], const f32x4 (&xx)[8], const float* g1, const float* g2, bf16_t* h1, bf16_t* U, int m, int lane) {
    float v[32]; float s = 0.f;
#pragma unroll
    for (int j = 0; j < 4; ++j) unpack8(mw[j], v + 8 * j);
#pragma unroll
    for (int e = 0; e < 32; ++e) s += v[e] * v[e];
    const float rstd = 1.0f / sqrtf(wave_sum(s) * (1.0f / DM) + EPS); float s2 = 0.f;
#pragma unroll
    for (int j = 0; j < 4; ++j) {
#pragma unroll
        for (int q = 0; q < 2; ++q) { const int c4 = (lane + 64 * j) * 2 + q; const f32x4 x4 = xx[2 * j + q], gg = ((const f32x4*)g1)[c4];
            v[8 * j + 4 * q] = x4.x + v[8 * j + 4 * q] * rstd * gg.x; v[8 * j + 4 * q + 1] = x4.y + v[8 * j + 4 * q + 1] * rstd * gg.y;
            v[8 * j + 4 * q + 2] = x4.z + v[8 * j + 4 * q + 2] * rstd * gg.z; v[8 * j + 4 * q + 3] = x4.w + v[8 * j + 4 * q + 3] * rstd * gg.w; }
    }
#pragma unroll
    for (int e = 0; e < 32; ++e) s2 += v[e] * v[e];
    const float rstd2 = 1.0f / sqrtf(wave_sum(s2) * (1.0f / DM) + EPS);
    u32x4* hp = (u32x4*)(h1 + (size_t)m * DM) + lane; u32x4* up = (u32x4*)(U + (size_t)m * DM) + lane;
#pragma unroll
    for (int j = 0; j < 4; ++j) { const int c4 = (lane + 64 * j) * 2; const f32x4 ga = ((const f32x4*)g2)[c4], gb = ((const f32x4*)g2)[c4 + 1]; u32x4 w;
        w.x = pk2(v[8 * j], v[8 * j + 1]); w.y = pk2(v[8 * j + 2], v[8 * j + 3]); w.z = pk2(v[8 * j + 4], v[8 * j + 5]); w.w = pk2(v[8 * j + 6], v[8 * j + 7]); hp[64 * j] = w;
        w.x = pk2(v[8 * j] * rstd2 * ga.x, v[8 * j + 1] * rstd2 * ga.y); w.y = pk2(v[8 * j + 2] * rstd2 * ga.z, v[8 * j + 3] * rstd2 * ga.w);
        w.z = pk2(v[8 * j + 4] * rstd2 * gb.x, v[8 * j + 5] * rstd2 * gb.y); w.w = pk2(v[8 * j + 6] * rstd2 * gb.z, v[8 * j + 7] * rstd2 * gb.w); up[64 * j] = w; }
}
__device__ __forceinline__ void rowO_load(const bf16_t* down, const bf16_t* h1, int m, int lane, u32x4 (&dw)[4], u32x4 (&hw)[4]) {
    const u32x4* dp = (const u32x4*)(down + (size_t)m * DM) + lane; const u32x4* hp = (const u32x4*)(h1 + (size_t)m * DM) + lane;
#pragma unroll
    for (int j = 0; j < 4; ++j) { dw[j] = dp[64 * j]; hw[j] = hp[64 * j]; }
}
__device__ __forceinline__ void rowO_finish(const u32x4 (&dw)[4], const u32x4 (&hw)[4], const float* g3, float* out, int m, int lane) {
    float v[32], h[32]; float s = 0.f;
#pragma unroll
    for (int j = 0; j < 4; ++j) { unpack8(dw[j], v + 8 * j); unpack8(hw[j], h + 8 * j); }
#pragma unroll
    for (int e = 0; e < 32; ++e) s += v[e] * v[e];
    const float rstd = 1.0f / sqrtf(wave_sum(s) * (1.0f / DM) + EPS);
    f32x4* op = (f32x4*)(out + (size_t)m * DM);
#pragma unroll
    for (int j = 0; j < 4; ++j)
#pragma unroll
        for (int q = 0; q < 2; ++q) { const int c4 = (lane + 64 * j) * 2 + q; const f32x4 gg = ((const f32x4*)g3)[c4]; f32x4 o;
            o.x = h[8 * j + 4 * q] + v[8 * j + 4 * q] * rstd * gg.x; o.y = h[8 * j + 4 * q + 1] + v[8 * j + 4 * q + 1] * rstd * gg.y;
            o.z = h[8 * j + 4 * q + 2] + v[8 * j + 4 * q + 2] * rstd * gg.z; o.w = h[8 * j + 4 * q + 3] + v[8 * j + 4 * q + 3] * rstd * gg.w; op[c4] = o; }
}

__device__ __forceinline__ void transpose_item(const float* __restrict__ W, int K, int N, bf16_t* __restrict__ WT, int k0, int n0, int drow, LAS float* scr, int lane) {
#pragma unroll 8
    for (int i = 0; i < 32; ++i) { const int kk = 2 * i + (lane >> 5); scr[kk * 33 + (lane & 31)] = W[(size_t)(k0 + kk) * N + n0 + (lane & 31)]; }
    asm volatile("s_waitcnt lgkmcnt(0)" ::: "memory");
    const int c = lane & 7;
#pragma unroll
    for (int j = 0; j < 4; ++j) { const int n = (lane >> 3) + 8 * j; const LAS float* s = scr + (8 * c) * 33 + n;
        u32x4 o; o.x = pk2(s[0 * 33], s[1 * 33]); o.y = pk2(s[2 * 33], s[3 * 33]); o.z = pk2(s[4 * 33], s[5 * 33]); o.w = pk2(s[6 * 33], s[7 * 33]);
        *(u32x4*)(WT + (size_t)(drow + n) * K + k0 + 8 * c) = o; }
    asm volatile("s_waitcnt lgkmcnt(0)" ::: "memory");
}
__device__ __forceinline__ int dst_row(int id, int n0) {
    switch (id) {
    case 0: return n0 < 4352 ? n0 : (n0 < 4416 ? 8448 + (n0 - 4352) : 4352 + (n0 - 4416));
    case 1: { const int h = n0 / 192, j = n0 % 192; return j < 128 ? h * 128 + j : 1024 + (h >> 2) * 256 + (j >= 160 ? 128 : 0) + (h & 3) * 32; }
    case 2: { const int h = n0 >> 8, j = n0 & 255; return j < 128 ? h * 128 + j : 1024 + h * 128 + (j - 128); }
    case 6: { const int up = n0 >= DFF, j = up ? n0 - DFF : n0; return (j >> 7) * 256 + (up ? 128 : 0) + (j & 127); }
    default: return n0;
    }
}

__global__ void __launch_bounds__(512) mk_fwd(Args args) {
    __builtin_assume(__builtin_amdgcn_workitem_id_y() == 0); __builtin_assume(__builtin_amdgcn_workitem_id_z() == 0);
    extern __shared__ __attribute__((aligned(16))) unsigned char lds_raw[];
    LAS unsigned char* lds = (LAS unsigned char*)lds_raw;
    cg::grid_group grid = cg::this_grid();
    const int wave = __builtin_amdgcn_readfirstlane(threadIdx.x >> 6);
    const int G = gridDim.x, bx = blockIdx.x;
    const int vcu = (G % 8 == 0) ? (bx % 8) * (G / 8) + bx / 8 : bx;
    const int gw = vcu * 8 + wave, NGW = G * 8;
    unsigned char* ws = args.ws;
    const int lo = args.ph_lo, hi_ = args.ph_hi;
    volatile LAS unsigned* bst = (volatile LAS unsigned*)(lds + XB_LDS_OFF);
    if (threadIdx.x < 2) bst[threadIdx.x] = 0u;
    __syncthreads();
    XcdBarrier xbar = xcd_barrier_post((unsigned*)ws + XB_WS_WORD, bst);
#define IN(k) (lo <= (k) && (k) < hi_)
#define SEAM(k) do { if (IN(k) && IN((k) + 1)) { if ((k) == 0) grid.sync(); else xcd_barrier(xbar); } } while (0)
    bf16_t* U = (bf16_t*)(ws + A_U);
    bf16_t* gates = (bf16_t*)(ws + A_GATES);
    bf16_t* h1 = (bf16_t*)(ws + A_GATES);

    if (IN(0)) {
        const int lane = lane_id();
        LAS float* scr = (LAS float*)(lds + wave * 16384);
        int base = 0;
#define CONV(id, Wp, Kk, Nn, Off) do { const int nblk = (Nn) / 32, items = ((Kk) / 64) * nblk; \
            for (int it = gw - base; it < items; it += NGW) { if (it < 0) continue; \
                const int kb = it / nblk, nb = it % nblk; transpose_item((Wp), (Kk), (Nn), (bf16_t*)(ws + (Off)), 64 * kb, 32 * nb, dst_row((id), 32 * nb), scr, lane); } \
            base = (base + items) % NGW; } while (0)
        CONV(0, args.in[3], 2048, 8512, W_IN); CONV(1, args.in[6], 768, 1536, W_UQ); CONV(2, args.in[8], 512, 2048, W_UKV); CONV(3, args.in[9], 1024, 2048, W_OSB);
        CONV(4, args.in[10], 1024, 2048, W_OMLA); CONV(5, args.in[11], 2048, 2048, W_OUT); CONV(6, args.in[14], 2048, 2 * DFF, W_GU); CONV(7, args.in[15], DFF, 2048, W_DN);
#undef CONV
        const float* g = args.in[2];
        for (int m = gw; m < T; m += RB * NGW) { f32x4 va[RB][8];
#pragma unroll
            for (int b = 0; b < RB; ++b) { const int mb = m + b * NGW; rowU_load(args.in[0], mb < T ? mb : m, lane, va[b]); }
#pragma unroll
            for (int b = 0; b < RB; ++b) { const int mb = m + b * NGW; if (mb < T) rowU_finish(va[b], g, U, mb, lane); } }
    }
    SEAM(0);
    if (IN(1)) {
        pg8::Gemm g{U, (const bf16_t*)(ws + W_IN), T, N1, 2048}; pg8::StaticOrder S; S.init(T, N1, G, bx);
        pg8::Epi1 E{(bf16_t*)(ws + A_QSB), (bf16_t*)(ws + A_QLAT), (bf16_t*)(ws + A_KVLAT), gates, (float*)(ws + A_KR), args.in[4]};
        pg8::gemm_phase<pg8::Epi1, pg8::StaticOrder, true, true>(lds, g, S, E);
    }
    SEAM(1);
    if (IN(2)) {
        const int lane = lane_id();
        const float* gq = args.in[5]; const float* gkv = args.in[7]; const int* pos = (const int*)args.in[1];
        const int i = lane & 31; const float invf = args.invf[i];
        for (int m = gw; m < T; m += RB * NGW) {
            u32x2 wq[RB][3], wk[RB][2]; float x1[RB], x2[RB], pf[RB];
#pragma unroll
            for (int b = 0; b < RB; ++b) { const int mb = (m + b * NGW < T) ? m + b * NGW : m;
                const u32x2* p = (const u32x2*)(ws + A_QLAT + (size_t)mb * 768 * 2) + lane; const u32x2* p2 = (const u32x2*)(ws + A_KVLAT + (size_t)mb * 512 * 2) + lane;
#pragma unroll
                for (int j = 0; j < 3; ++j) wq[b][j] = p[64 * j];
#pragma unroll
                for (int j = 0; j < 2; ++j) wk[b][j] = p2[64 * j];
                const float* kr = (const float*)(ws + A_KR) + (size_t)mb * 64; x1[b] = kr[i]; x2[b] = kr[i + 32]; pf[b] = (float)pos[mb]; }
#pragma unroll
            for (int b = 0; b < RB; ++b) { const int mb = m + b * NGW; if (mb < T) {
                { u32x2* p = (u32x2*)(ws + A_QLAT + (size_t)mb * 768 * 2) + lane; float s = 0.f;
#pragma unroll
                  for (int j = 0; j < 3; ++j) { const float a = bflo(wq[b][j].x), bb = bfhi(wq[b][j].x), c = bflo(wq[b][j].y), d = bfhi(wq[b][j].y); s += (a * a + bb * bb) + (c * c + d * d); }
                  const float rstd = 1.0f / sqrtf(wave_sum(s) * (1.0f / 768.0f) + EPS);
#pragma unroll
                  for (int j = 0; j < 3; ++j) { const f32x4 gg = *((const f32x4*)gq + lane + 64 * j); u32x2 o; o.x = pk2(bflo(wq[b][j].x) * rstd * gg.x, bfhi(wq[b][j].x) * rstd * gg.y); o.y = pk2(bflo(wq[b][j].y) * rstd * gg.z, bfhi(wq[b][j].y) * rstd * gg.w); p[64 * j] = o; } }
                { u32x2* p = (u32x2*)(ws + A_KVLAT + (size_t)mb * 512 * 2) + lane; float s = 0.f;
#pragma unroll
                  for (int j = 0; j < 2; ++j) { const float a = bflo(wk[b][j].x), bb = bfhi(wk[b][j].x), c = bflo(wk[b][j].y), d = bfhi(wk[b][j].y); s += (a * a + bb * bb) + (c * c + d * d); }
                  const float rstd = 1.0f / sqrtf(wave_sum(s) * (1.0f / 512.0f) + EPS);
#pragma unroll
                  for (int j = 0; j < 2; ++j) { const f32x4 gg = *((const f32x4*)gkv + lane + 64 * j); u32x2 o; o.x = pk2(bflo(wk[b][j].x) * rstd * gg.x, bfhi(wk[b][j].x) * rstd * gg.y); o.y = pk2(bflo(wk[b][j].y) * rstd * gg.z, bfhi(wk[b][j].y) * rstd * gg.w); p[64 * j] = o; } }
                { const float ang = pf[b] * invf;
                  double rev = (double)ang * 0.15915494309189535; rev -= floor(rev); const float rf = (float)rev;
                  const float sn = __builtin_amdgcn_sinf(rf), cn = __builtin_amdgcn_cosf(rf);
                  float* cs = (float*)(ws + A_CS) + (size_t)mb * 64; bf16_t* ko = (bf16_t*)(ws + A_KROPE) + (size_t)mb * 64;
                  if (lane < 32) { cs[i] = cn; ko[i] = (bf16_t)f2bf(x1[b] * cn - x2[b] * sn); } else { cs[32 + i] = sn; ko[32 + i] = (bf16_t)f2bf(x2[b] * cn + x1[b] * sn); } }
            } }
        }
    }
    SEAM(2);
    if (IN(3)) {
        { pg8::Gemm g{(const bf16_t*)(ws + A_QLAT), (const bf16_t*)(ws + W_UQ), T, 1536, 768}; pg8::StaticOrder S; S.init(T, 1536, G, bx);
          pg8::EpiQ E{(bf16_t*)(ws + A_Q), (const float*)(ws + A_CS)}; pg8::gemm_phase<pg8::EpiQ, pg8::StaticOrder, true, true>(lds, g, S, E); }
        { pg8::Gemm g{(const bf16_t*)(ws + A_KVLAT), (const bf16_t*)(ws + W_UKV), T, 2048, 512}; pg8::StaticOrder S; S.init(T, 2048, G, bx);
          pg8::EpiKV E{(bf16_t*)(ws + A_KN)}; pg8::gemm_phase<pg8::EpiKV, pg8::StaticOrder, true, true>(lds, g, S, E); }
    }
    SEAM(3);
    if (IN(4)) {
        const int nvc = (G % 16 == 0) ? G / 16 : 0;
        if (nvc) {
            const int bh = vcu / nvc, s = vcu % nvc, npb = 64 / nvc;
            for (int i = npb - 1; i >= 0; --i) { const int pr = (i >> 1) * nvc + s, qb = (i & 1) ? 63 - pr : pr;
                att::attn_unit<true>(lds, bh >> 3, bh & 7, qb, (const bf16_t*)(ws + A_Q), (const bf16_t*)(ws + A_KN), (const bf16_t*)(ws + A_KROPE), (const bf16_t*)(ws + A_VM), (bf16_t*)(ws + A_MLAO)); }
            for (int i = 0; i < npb; ++i) { const int qb = i * nvc + s;
                att::attn_unit<false>(lds, bh >> 3, bh & 7, qb, (const bf16_t*)(ws + A_QSB), (const bf16_t*)(ws + A_KSB), nullptr, (const bf16_t*)(ws + A_VSB), (bf16_t*)(ws + A_SBO)); }
        } else {
            for (int u = bx; u < 1024; u += G) { const int bh = u >> 6, qb = 63 - (u & 63);
                att::attn_unit<true>(lds, bh >> 3, bh & 7, qb, (const bf16_t*)(ws + A_Q), (const bf16_t*)(ws + A_KN), (const bf16_t*)(ws + A_KROPE), (const bf16_t*)(ws + A_VM), (bf16_t*)(ws + A_MLAO));
                att::attn_unit<false>(lds, bh >> 3, bh & 7, qb, (const bf16_t*)(ws + A_QSB), (const bf16_t*)(ws + A_KSB), nullptr, (const bf16_t*)(ws + A_VSB), (bf16_t*)(ws + A_SBO)); }
        }
    }
    SEAM(4);
    if (IN(5)) {
        { pg8::Gemm g{(const bf16_t*)(ws + A_SBO), (const bf16_t*)(ws + W_OSB), T, 2048, 1024}; pg8::StaticOrder S; S.init(T, 2048, G, bx);
          pg8::EpiGate<false> E{gates, (bf16_t*)(ws + A_TMP), U}; pg8::gemm_phase<pg8::EpiGate<false>, pg8::StaticOrder, true, true>(lds, g, S, E); }
    }
    if (IN(6)) {
        { pg8::Gemm g{(const bf16_t*)(ws + A_MLAO), (const bf16_t*)(ws + W_OMLA), T, 2048, 1024}; pg8::StaticOrder S; S.init(T, 2048, G, bx);
          pg8::EpiGate<true> E{gates, (bf16_t*)(ws + A_TMP), U}; pg8::gemm_phase<pg8::EpiGate<true>, pg8::StaticOrder, true, true>(lds, g, S, E); }
    }
    SEAM(6);
    if (IN(7)) {
        pg8::Gemm g{U, (const bf16_t*)(ws + W_OUT), T, 2048, 2048}; pg8::StaticOrder S; S.init(T, 2048, G, bx);
        pg8::EpiPlain E{(bf16_t*)(ws + A_MIXED), 2048}; pg8::gemm_phase<pg8::EpiPlain, pg8::StaticOrder, true, true>(lds, g, S, E);
    }
    SEAM(7);
    if (IN(8)) {
        const int lane = lane_id();
        const float* g1 = args.in[12]; const float* g2 = args.in[13]; const bf16_t* mixed = (const bf16_t*)(ws + A_MIXED);
        for (int m = gw; m < T; m += RBH * NGW) { u32x4 ma[RBH][4]; f32x4 xa[RBH][8];
#pragma unroll
            for (int b = 0; b < RBH; ++b) { const int mb = m + b * NGW; rowH_load(mixed, args.in[0], mb < T ? mb : m, lane, ma[b], xa[b]); }
#pragma unroll
            for (int b = 0; b < RBH; ++b) { const int mb = m + b * NGW; if (mb < T) rowH_finish(ma[b], xa[b], g1, g2, h1, U, mb, lane); } }
    }
    SEAM(8);
    if (IN(9)) {
        pg8::Gemm g{U, (const bf16_t*)(ws + W_GU), T, 2 * DFF, 2048}; pg8::StaticOrder S; S.init(T, 2 * DFF, G, bx);
        pg8::EpiSwiglu E{(bf16_t*)(ws + A_ACT)}; pg8::gemm_phase<pg8::EpiSwiglu, pg8::StaticOrder, true, true>(lds, g, S, E);
    }
    SEAM(9);
    if (IN(10)) {
        pg8::Gemm g{(const bf16_t*)(ws + A_ACT), (const bf16_t*)(ws + W_DN), T, 2048, DFF}; pg8::StaticOrder S; S.init(T, 2048, G, bx);
        pg8::EpiPlain E{U, 2048}; pg8::gemm_phase<pg8::EpiPlain, pg8::StaticOrder, true, true>(lds, g, S, E);
    }
    SEAM(10);
    if (IN(11)) {
        const int lane = lane_id();
        const float* g3 = args.in[16];
        for (int m = gw; m < T; m += RB * NGW) { u32x4 da[RB][4], ha[RB][4];
#pragma unroll
            for (int b = 0; b < RB; ++b) { const int mb = m + b * NGW; rowO_load(U, h1, mb < T ? mb : m, lane, da[b], ha[b]); }
#pragma unroll
            for (int b = 0; b < RB; ++b) { const int mb = m + b * NGW; if (mb < T) rowO_finish(da[b], ha[b], g3, args.out, mb, lane); } }
    }
#undef IN
#undef SEAM
}

extern "C" void kernel_launch(void* const* d_in, const int* in_sizes, int n_in, void* d_out, int out_size, void* d_ws, size_t ws_size, hipStream_t stream) {
    static int grid = 0;
    if (grid == 0) {
        if (n_in != 17 || out_size != T * DM || ws_size < WS_NEED) { fprintf(stderr, "kernel_launch: unexpected shapes (n_in %d out %d ws %zu)\n", n_in, out_size, ws_size); grid = -1; return; }
        int dev = 0, cus = 0, per_cu = 0;
        hipGetDevice(&dev); hipDeviceGetAttribute(&cus, hipDeviceAttributeMultiprocessorCount, dev);
        hipFuncSetAttribute((const void*)mk_fwd, hipFuncAttributeMaxDynamicSharedMemorySize, LDS_BYTES);
        hipOccupancyMaxActiveBlocksPerMultiprocessor(&per_cu, (const void*)mk_fwd, 512, LDS_BYTES);
        (void)hipGetLastError();
        if (per_cu < 1) per_cu = 1;
        grid = cus;
    }
    if (grid < 0) return;
#ifdef EXP_MEMSET_OUT
    (void)hipMemsetAsync(d_out, 0, (size_t)out_size * 4, stream);
#endif
#ifdef EXP_MEMSET_ALL
    (void)hipMemsetAsync(d_ws, 0xAA, WS_NEED, stream);
#endif
#ifdef EXP_MEMSET_QKV
    (void)hipMemsetAsync((char*)d_ws + A_QSB, 0, (size_t)192 * MiB, stream);
#endif
    (void)hipMemsetAsync(d_ws, 0, 65536, stream);
    Args a{};
    for (int i = 0; i < 17; ++i) a.in[i] = (const float*)d_in[i];
    a.out = (float*)d_out; a.ws = (unsigned char*)d_ws;
    for (int i = 0; i < 32; ++i) a.invf[i] = (float)pow(10000.0, -(double)i / 32.0);
#if MK_COOP
    a.ph_lo = 0; a.ph_hi = NPH;
    void* kargs[] = {&a};
    hipError_t e = hipLaunchCooperativeKernel((const void*)mk_fwd, dim3(grid), dim3(512), kargs, LDS_BYTES, stream);
    if (e != hipSuccess) fprintf(stderr, "cooperative launch failed: %s (grid %d)\n", hipGetErrorString(e), grid);
#else
    for (int p = 0; p < NPH; ++p) { a.ph_lo = p; a.ph_hi = p + 1; hipLaunchKernelGGL(mk_fwd, dim3(grid), dim3(512), LDS_BYTES, stream, a); }
#endif
}
```

```cpp
#include <hip/hip_runtime.h>
#include <cstdio>
#include <cstdint>
#include <cmath>
namespace pg8 {
#define PG8_LAS __attribute__((address_space(3)))
typedef unsigned short bf16_t;
typedef short bf16x8 __attribute__((ext_vector_type(8)));
typedef float f32x4 __attribute__((ext_vector_type(4)));
typedef unsigned u32x4 __attribute__((ext_vector_type(4)));
constexpr int BM = 256, BK = 64, HALF = 128, HTB = HALF * BK * 2  , STAGE_BYTES = 8 * HTB, NXCD = 8, WGM = 8;

__host__ __device__ __forceinline__ int lds_byte(int r, int c) { const int st = (r >> 4) * 2 + (c >> 5), rr = r & 15, cc = c & 31, ob = rr * 64 + cc * 2; return st * 1024 + (ob ^ (((ob >> 9) & 1) << 5)); }
__host__ __device__ __forceinline__ void stage_rc(int b, int& R, int& C) { const int st = b / 1024, sb = b % 1024, swz = sb ^ (((sb >> 9) & 1) << 5); R = (st >> 1) * 16 + swz / 64; C = (st & 1) * 32 + (swz % 64) / 2; }
__host__ __device__ __forceinline__ int perm32(int rho) { const int n = rho >> 4, i = rho & 15; return 8 * (i >> 2) + 4 * n + (i & 3); }

struct Unit { int pm, pn; };
struct Gemm { const bf16_t* A; const bf16_t* Bt; int M, N, K; };

struct StaticOrder {
    int nM, nN, nwg, G, c;
    __host__ __device__ void init(int M, int N, int G_, int c_) { nM = M / BM; nN = N / BM; nwg = nM * nN; G = G_; c = c_; }
    __host__ __device__ bool next(int i, Unit& u) const {
        const long L = (long)i * G + c; if (L >= nwg) return false;
        int wgid = (int)L; { const int q = nwg / NXCD, r = nwg % NXCD, xcd = wgid % NXCD, off = wgid / NXCD; wgid = (xcd < r ? xcd * (q + 1) : r * (q + 1) + (xcd - r) * q) + off; }
        const int nig = WGM * nN, gid = wgid / nig, fm = gid * WGM, gsz = (nM - fm) < WGM ? (nM - fm) : WGM;
        u.pm = fm + ((wgid % nig) % gsz); u.pn = (wgid % nig) / gsz; return true;
    }
    __device__ __forceinline__ void a_ready(const Unit&) const {}
    __device__ __forceinline__ void done(const Unit&) const {}
};

__device__ __forceinline__ unsigned cvt_pk_bf16(float lo, float hi) { typedef float f2_ __attribute__((ext_vector_type(2))); typedef __bf16 b2_ __attribute__((ext_vector_type(2))); f2_ v = {lo, hi}; b2_ b = __builtin_convertvector(v, b2_); return __builtin_bit_cast(unsigned, b); }
typedef float f32x2 __attribute__((ext_vector_type(2)));
__device__ __forceinline__ f32x2 gelu_pk(f32x2 v) {
    const f32x2 av = __builtin_elementwise_abs(v), d = av * 0.2316418882f + 1.0f;
    f32x2 t; t.x = __builtin_amdgcn_rcpf(d.x); t.y = __builtin_amdgcn_rcpf(d.y);
    f32x2 q = t * 0.5307027145f + (-0.7265760135f); q = q * t + 0.7107068705f; q = q * t + (-0.142248368f); q = q * t + 0.127414796f; q = q * t;
    const f32x2 s = (v * v) * (-0.72134752044f);
    f32x2 e; e.x = __builtin_amdgcn_exp2f(s.x); e.y = __builtin_amdgcn_exp2f(s.y);
    const f32x2 m = v * (q * e), r = v - m;
    f32x2 o; o.x = v.x < 0.f ? m.x : r.x; o.y = v.y < 0.f ? m.y : r.y; return o;
}

template <class Epi, class Sched, bool ALIGN_EPI = false, bool SP2 = false>
__device__ __forceinline__ void gemm_phase(PG8_LAS unsigned char* lds, const Gemm g, const Sched& S, const Epi& E) {
    const int tid = threadIdx.x, wid = __builtin_amdgcn_readfirstlane(tid >> 6), lane = tid & 63, wr = wid >> 2, wc = wid & 3, fr = lane & 15, fq = lane >> 4;
    const int K = g.K, nt = K / BK;
    unsigned voffA[2], voffB[2];
#pragma unroll
    for (int i = 0; i < 2; ++i) { int R, C; stage_rc(tid * 16 + i * 8192, R, C); const int Rb = Epi::PERM ? ((R & ~31) + perm32(R & 31)) : R;
        voffA[i] = (unsigned)(R * K + C) * 2u; voffB[i] = (unsigned)(Rb * K + C) * 2u; }
    const size_t kstep = (size_t)(BK * 2);
    const size_t hstep = (size_t)HALF * K * 2;
    const size_t tstep = 2 * hstep;
    const unsigned ldsw = (unsigned)wid * 1024u;
    const int aoff = lds_byte(wr * 64 + fr, fq * 8), boff = lds_byte(wc * 32 + fr, fq * 8);
#define PG8_SA(b, h) (((b) * 2 + (h)) * HTB)
#define PG8_SB(b, h) ((4 + (b) * 2 + (h)) * HTB)
#define PG8_STAGE(bufoff, gbase, voff) do { _Pragma("unroll") for (int _i = 0; _i < 2; ++_i) \
        __builtin_amdgcn_global_load_lds((const unsigned*)((const char*)(gbase) + (voff)[_i]), (PG8_LAS unsigned*)(lds + (bufoff) + ldsw + _i * 8192), 16, 0, 0); } while (0)
#define PG8_LDA(dst, b, h) do { _Pragma("unroll") for (int m = 0; m < 4; ++m) _Pragma("unroll") for (int k = 0; k < 2; ++k) dst[m][k] = *(const PG8_LAS bf16x8*)(lds + PG8_SA(b, h) + aoff + m * 2048 + k * 1024); } while (0)
#define PG8_LDB(dst, b, h) do { _Pragma("unroll") for (int n = 0; n < 2; ++n) _Pragma("unroll") for (int k = 0; k < 2; ++k) dst[n][k] = *(const PG8_LAS bf16x8*)(lds + PG8_SB(b, h) + boff + n * 2048 + k * 1024); } while (0)
#define PG8_MMA(ai, bj, At, Bt) do { __builtin_amdgcn_s_setprio(1); _Pragma("unroll") for (int m = 0; m < 4; ++m) _Pragma("unroll") for (int n = 0; n < 2; ++n) _Pragma("unroll") for (int k = 0; k < 2; ++k) \
        acc[ai][bj][m][n] = __builtin_amdgcn_mfma_f32_16x16x32_bf16(Bt[n][k], At[m][k], acc[ai][bj][m][n], 0, 0, 0); __builtin_amdgcn_s_setprio(0); } while (0)
#define PG8_WAIT_V(n) asm volatile("s_waitcnt vmcnt(" #n ")" ::: "memory")
#define PG8_WAIT_L(n) asm volatile("s_waitcnt lgkmcnt(" #n ")" ::: "memory")
#define PG8_BAR __builtin_amdgcn_s_barrier()
#define PG8_SCHED __builtin_amdgcn_sched_barrier(0)
    Unit cur, nxt; int ui = 0;
    if (!S.next(0, cur)) return;
    f32x4 acc[2][2][4][2];
#pragma unroll
    for (int a = 0; a < 2; ++a)
#pragma unroll
        for (int b = 0; b < 2; ++b)
#pragma unroll
            for (int m = 0; m < 4; ++m)
#pragma unroll
                for (int n = 0; n < 2; ++n) acc[a][b][m][n] = (f32x4){0.f, 0.f, 0.f, 0.f};
    bf16x8 At[4][2], B0[2][2], B1[2][2];
    const char* cA = (const char*)g.A + (size_t)cur.pm * tstep; const char* cB = (const char*)g.Bt + (size_t)cur.pn * tstep;
    S.a_ready(cur);
    if constexpr (SP2) {
        PG8_STAGE(PG8_SB(0, 0), cB, voffB); PG8_STAGE(PG8_SB(0, 1), cB + hstep, voffB); PG8_STAGE(PG8_SA(0, 0), cA, voffA); PG8_STAGE(PG8_SA(0, 1), cA + hstep, voffA);
        if (wr == 1) PG8_BAR;
        PG8_WAIT_V(2); PG8_BAR;
        PG8_STAGE(PG8_SB(1, 0), cB + kstep, voffB); PG8_STAGE(PG8_SA(1, 0), cA + kstep, voffA); PG8_STAGE(PG8_SB(1, 1), cB + hstep + kstep, voffB);
        PG8_WAIT_V(6); PG8_BAR;
    } else {
        PG8_STAGE(PG8_SB(0, 0), cB, voffB); PG8_STAGE(PG8_SA(0, 0), cA, voffA); PG8_STAGE(PG8_SB(0, 1), cB + hstep, voffB); PG8_STAGE(PG8_SA(0, 1), cA + hstep, voffA);
        if (wr == 1) PG8_BAR;
        PG8_WAIT_V(4); PG8_BAR;
        PG8_STAGE(PG8_SB(1, 0), cB + kstep, voffB); PG8_STAGE(PG8_SA(1, 0), cA + kstep, voffA); PG8_STAGE(PG8_SB(1, 1), cB + hstep + kstep, voffB);
        PG8_WAIT_V(6); PG8_BAR;
    }
    for (;;) {
        const bool has_next = S.next(ui + 1, nxt);
        const char* nA = has_next ? (const char*)g.A + (size_t)nxt.pm * tstep : cA; const char* nB = has_next ? (const char*)g.Bt + (size_t)nxt.pn * tstep : cB;
        for (int t = 0; t < nt; t += 2) {
            const bool last = (t == nt - 2);
            const char* a1 = cA + (size_t)(t + 1) * kstep;
            const char* a2 = last ? nA : cA + (size_t)(t + 2) * kstep; const char* b2 = last ? nB : cB + (size_t)(t + 2) * kstep;
            const char* a3 = a2 + kstep; const char* b3 = b2 + kstep;
            if (last && has_next) S.a_ready(nxt);
            if constexpr (SP2) {
            PG8_LDB(B0, 0, 0); PG8_LDB(B1, 0, 1); PG8_SCHED; PG8_LDA(At, 0, 0); PG8_STAGE(PG8_SA(1, 1), a1 + hstep, voffA);
            PG8_WAIT_V(8); PG8_WAIT_L(0); PG8_BAR; PG8_MMA(0, 0, At, B0); PG8_MMA(0, 1, At, B1); PG8_BAR; PG8_SCHED;
            PG8_LDA(At, 0, 1); PG8_STAGE(PG8_SB(0, 0), b2, voffB); PG8_STAGE(PG8_SB(0, 1), b2 + hstep, voffB); PG8_STAGE(PG8_SA(0, 0), a2, voffA);
            PG8_WAIT_V(8); PG8_WAIT_L(0); PG8_BAR; PG8_MMA(1, 0, At, B0); PG8_MMA(1, 1, At, B1); PG8_BAR; PG8_SCHED;
            PG8_LDB(B0, 1, 0); PG8_LDB(B1, 1, 1); PG8_SCHED; PG8_LDA(At, 1, 0); PG8_STAGE(PG8_SA(0, 1), a2 + hstep, voffA);
            PG8_WAIT_V(8); PG8_WAIT_L(0); PG8_BAR; PG8_MMA(0, 0, At, B0); PG8_MMA(0, 1, At, B1); PG8_BAR; PG8_SCHED;
            PG8_LDA(At, 1, 1); PG8_STAGE(PG8_SB(1, 0), b3, voffB); PG8_STAGE(PG8_SB(1, 1), b3 + hstep, voffB); PG8_STAGE(PG8_SA(1, 0), a3, voffA);
            PG8_WAIT_V(8); PG8_WAIT_L(0); PG8_BAR; PG8_MMA(1, 0, At, B0); PG8_MMA(1, 1, At, B1); PG8_BAR; PG8_SCHED;
            } else {
            PG8_LDB(B0, 0, 0); PG8_SCHED; PG8_LDA(At, 0, 0); PG8_STAGE(PG8_SA(1, 1), a1 + hstep, voffA);
            PG8_WAIT_L(8); PG8_BAR; PG8_WAIT_L(0); PG8_MMA(0, 0, At, B0); PG8_BAR; PG8_SCHED;
            PG8_LDB(B1, 0, 1); PG8_STAGE(PG8_SB(0, 0), b2, voffB);
            PG8_BAR; PG8_WAIT_L(0); PG8_MMA(0, 1, At, B1); PG8_BAR;
            PG8_LDA(At, 0, 1); PG8_STAGE(PG8_SA(0, 0), a2, voffA);
            PG8_BAR; PG8_WAIT_L(0); PG8_MMA(1, 0, At, B0); PG8_BAR; PG8_SCHED;
            PG8_STAGE(PG8_SB(0, 1), b2 + hstep, voffB);
            PG8_WAIT_V(6); PG8_BAR; PG8_MMA(1, 1, At, B1); PG8_BAR;
            PG8_LDB(B0, 1, 0); PG8_SCHED; PG8_LDA(At, 1, 0); PG8_STAGE(PG8_SA(0, 1), a2 + hstep, voffA);
            PG8_WAIT_L(8); PG8_BAR; PG8_WAIT_L(0); PG8_MMA(0, 0, At, B0); PG8_BAR; PG8_SCHED;
            PG8_LDB(B1, 1, 1); PG8_STAGE(PG8_SB(1, 0), b3, voffB);
            PG8_BAR; PG8_WAIT_L(0); PG8_MMA(0, 1, At, B1); PG8_BAR;
            PG8_LDA(At, 1, 1); PG8_STAGE(PG8_SA(1, 0), a3, voffA);
            PG8_BAR; PG8_WAIT_L(0); PG8_MMA(1, 0, At, B0); PG8_BAR; PG8_SCHED;
            PG8_STAGE(PG8_SB(1, 1), b3 + hstep, voffB);
            PG8_WAIT_V(6); PG8_BAR; PG8_MMA(1, 1, At, B1); PG8_BAR;
            }
        }
        if constexpr (ALIGN_EPI) { if (wr == 0) PG8_BAR; }
        if constexpr (!Epi::AFTER_DRAIN) { E(acc, cur, wr, wc, fr, fq); S.done(cur); }
        if (!has_next) break;
#pragma unroll
        for (int a = 0; a < 2; ++a)
#pragma unroll
            for (int b = 0; b < 2; ++b)
#pragma unroll
                for (int m = 0; m < 4; ++m)
#pragma unroll
                    for (int n = 0; n < 2; ++n) acc[a][b][m][n] = (f32x4){0.f, 0.f, 0.f, 0.f};
        cur = nxt; cA = nA; cB = nB; ++ui;
        if constexpr (ALIGN_EPI) { if (wr == 1) PG8_BAR; }
    }
    PG8_WAIT_V(0);
    if constexpr (!ALIGN_EPI) { if (wr == 0) PG8_BAR; }
    PG8_BAR;
    if constexpr (Epi::AFTER_DRAIN) { E.fused(acc, cur, wr, wc, fr, fq, lds, wid, lane); S.done(cur); }
#undef PG8_SA
#undef PG8_SB
#undef PG8_STAGE
#undef PG8_LDA
#undef PG8_LDB
#undef PG8_MMA
#undef PG8_WAIT_V
#undef PG8_WAIT_L
#undef PG8_BAR
#undef PG8_SCHED
}
}
#define LAS __attribute__((address_space(3)))
typedef pg8::bf16_t bf16_t;
typedef short bf16x8 __attribute__((ext_vector_type(8)));
typedef short s16x4 __attribute__((ext_vector_type(4)));
typedef float f32x4 __attribute__((ext_vector_type(4)));
typedef float f32x16 __attribute__((ext_vector_type(16)));
typedef unsigned u32x4 __attribute__((ext_vector_type(4)));
typedef unsigned u32x2 __attribute__((ext_vector_type(2)));

constexpr int BATCH = 2, SEQ = 16384, T = BATCH * SEQ, DM = 2048, DFF = 5632;
constexpr int N1 = 8704;
constexpr float EPS = 1e-6f;
constexpr float LOG2E = 1.4426950408889634f, LN2 = 0.6931471805599453f;
constexpr float SB_SCALE = 0.08838834764831845f;
constexpr float MLA_C2 = 0.07216878364870323f * LOG2E;
constexpr float SB_EXIT = -110.0f;

constexpr size_t MiB = 1u << 20;
constexpr size_t W_IN = 1 * MiB;
constexpr size_t W_UQ = W_IN + (size_t)N1 * 2048 * 2;
constexpr size_t W_UKV = W_UQ + (size_t)1536 * 768 * 2;
constexpr size_t W_OSB = W_UKV + (size_t)2048 * 512 * 2;
constexpr size_t W_OMLA = W_OSB + (size_t)2048 * 1024 * 2;
constexpr size_t W_OUT = W_OMLA + (size_t)2048 * 1024 * 2;
constexpr size_t W_GU = W_OUT + (size_t)2048 * 2048 * 2;
constexpr size_t W_DN = W_GU + (size_t)11264 * 2048 * 2;
constexpr size_t W_END = W_DN + (size_t)2048 * 5632 * 2;
static_assert(W_END <= 122 * MiB, "weights region");
constexpr size_t A_U = 122 * MiB;
constexpr size_t A_QSB = 250 * MiB;
constexpr size_t A_KSB = 314 * MiB;
constexpr size_t A_VSB = 378 * MiB;
constexpr size_t A_TMP = A_KSB;
constexpr size_t A_QLAT = 442 * MiB;
constexpr size_t A_KVLAT = 490 * MiB;
constexpr size_t A_MLAO = A_QLAT;
constexpr size_t A_KR = 522 * MiB;
constexpr size_t A_KROPE = 530 * MiB;
constexpr size_t A_CS = 534 * MiB;
constexpr size_t A_Q = 542 * MiB;
constexpr size_t A_KN = 638 * MiB;
constexpr size_t A_VM = 702 * MiB;
constexpr size_t A_MIXED = A_Q;
constexpr size_t A_ACT = 250 * MiB;
constexpr size_t A_SBO = A_U;
constexpr size_t A_GATES = 766 * MiB;
constexpr size_t WS_NEED = 1022 * MiB;
static_assert(A_KSB - A_QSB == (size_t)T * 2048 && A_VSB - A_KSB == (size_t)T * 2048 && A_VM - A_KN == (size_t)T * 2048, "contiguous q/k/v");
static_assert(A_ACT + (size_t)T * DFF * 2 <= WS_NEED && A_VM + (size_t)T * 1024 * 2 <= WS_NEED, "ws map");

constexpr int LDS_BYTES = 147456;
constexpr int XB_LDS_OFF = 139264;
constexpr int XB_WS_WORD = 4096;

__device__ __forceinline__ unsigned f2bf(float f) { unsigned u = __builtin_bit_cast(unsigned, f); return (u + 0x7fffu + ((u >> 16) & 1u)) >> 16; }
__device__ __forceinline__ unsigned pk2(float lo, float hi) { return f2bf(lo) | (f2bf(hi) << 16); }
__device__ __forceinline__ float bflo(unsigned w) { return __builtin_bit_cast(float, w << 16); }
__device__ __forceinline__ float bfhi(unsigned w) { return __builtin_bit_cast(float, w & 0xffff0000u); }
__device__ __forceinline__ float ex2(float x) { return __builtin_amdgcn_exp2f(x); }
__device__ __forceinline__ float sigmoidf_(float x) { return __builtin_amdgcn_rcpf(1.0f + ex2(-x * LOG2E)); }
__device__ __forceinline__ int lane_id() { int l; asm volatile("v_mbcnt_lo_u32_b32 %0, -1, 0\n\tv_mbcnt_hi_u32_b32 %0, -1, %0" : "=v"(l)); return l; }
__device__ __forceinline__ float wave_sum(float v) {
#pragma unroll
    for (int o = 1; o < 64; o <<= 1) v += __shfl_xor(v, o);
    return v;
}

namespace pg8 {
typedef const f32x4 (&AccRef)[2][2][4][2];
__device__ __forceinline__ void store_tile_bf16(AccRef acc, bf16_t* base, int ld, int rowb, int c0, float sc) {
#pragma unroll
    for (int ai = 0; ai < 2; ++ai)
#pragma unroll
        for (int m = 0; m < 4; ++m) { bf16_t* rowp = base + (size_t)(rowb + ai * HALF + m * 16) * ld + c0;
#pragma unroll
            for (int bj = 0; bj < 2; ++bj) { const f32x4 v0 = acc[ai][bj][m][0] * sc, v1 = acc[ai][bj][m][1] * sc; u32x4 w;
                w.x = cvt_pk_bf16(v0[0], v0[1]); w.y = cvt_pk_bf16(v0[2], v0[3]); w.z = cvt_pk_bf16(v1[0], v1[1]); w.w = cvt_pk_bf16(v1[2], v1[3]);
                *(u32x4*)(rowp + bj * HALF) = w; } }
}
struct Epi1 {
    static constexpr bool PERM = true, AFTER_DRAIN = false;
    bf16_t *qkv  , *qlat, *kvlat, *gates; float* kr; const float* bgate;
    __device__ __forceinline__ void operator()(AccRef acc, const Unit& u, int wr, int wc, int fr, int fq) const {
        const int pn = u.pn, rowb = u.pm * BM + wr * 64 + fr, cw = wc * 32 + 8 * fq;
        if (pn < 12) { bf16_t* base = qkv + (size_t)(pn >> 2) * ((size_t)T * 1024); store_tile_bf16(acc, base, 1024, rowb, (pn & 3) * 256 + cw, pn < 4 ? SB_SCALE : 1.0f); }
        else if (pn < 15) store_tile_bf16(acc, qlat, 768, rowb, (pn - 12) * 256 + cw, 1.0f);
        else if (pn < 17) store_tile_bf16(acc, kvlat, 512, rowb, (pn - 15) * 256 + cw, 1.0f);
        else if (pn < 33) {
            const int c0 = (pn - 17) * 256 + cw;
            f32x4 bv[2][2];
#pragma unroll
            for (int bj = 0; bj < 2; ++bj)
#pragma unroll
                for (int n = 0; n < 2; ++n) bv[bj][n] = *(const f32x4*)(bgate + c0 + bj * HALF + 4 * n);
#pragma unroll
            for (int ai = 0; ai < 2; ++ai)
#pragma unroll
                for (int m = 0; m < 4; ++m) { bf16_t* rowp = gates + (size_t)(rowb + ai * HALF + m * 16) * 4096 + c0;
#pragma unroll
                    for (int bj = 0; bj < 2; ++bj) { const f32x4 v0 = acc[ai][bj][m][0] + bv[bj][0], v1 = acc[ai][bj][m][1] + bv[bj][1]; u32x4 w;
                        w.x = cvt_pk_bf16(sigmoidf_(v0[0]), sigmoidf_(v0[1])); w.y = cvt_pk_bf16(sigmoidf_(v0[2]), sigmoidf_(v0[3]));
                        w.z = cvt_pk_bf16(sigmoidf_(v1[0]), sigmoidf_(v1[1])); w.w = cvt_pk_bf16(sigmoidf_(v1[2]), sigmoidf_(v1[3]));
                        *(u32x4*)(rowp + bj * HALF) = w; } }
        } else if (wc < 2) {
#pragma unroll
            for (int ai = 0; ai < 2; ++ai)
#pragma unroll
                for (int m = 0; m < 4; ++m) { float* rowp = kr + (size_t)(rowb + ai * HALF + m * 16) * 64 + cw;
                    *(f32x4*)rowp = acc[ai][0][m][0]; *(f32x4*)(rowp + 4) = acc[ai][0][m][1]; }
        }
    }
};
struct EpiQ {
    static constexpr bool PERM = true, AFTER_DRAIN = false;
    bf16_t* q; const float* cs;
    __device__ __forceinline__ void operator()(AccRef acc, const Unit& u, int wr, int wc, int fr, int fq) const {
        const int pn = u.pn, rowb = u.pm * BM + wr * 64 + fr, cw = wc * 32 + 8 * fq;
        if (pn < 4) {
#pragma unroll
            for (int ai = 0; ai < 2; ++ai)
#pragma unroll
                for (int m = 0; m < 4; ++m) { bf16_t* rowp = q + (size_t)(rowb + ai * HALF + m * 16) * 1536 + cw;
#pragma unroll
                    for (int bj = 0; bj < 2; ++bj) { const f32x4 v0 = acc[ai][bj][m][0] * MLA_C2, v1 = acc[ai][bj][m][1] * MLA_C2; u32x4 w;
                        w.x = cvt_pk_bf16(v0[0], v0[1]); w.y = cvt_pk_bf16(v0[2], v0[3]); w.z = cvt_pk_bf16(v1[0], v1[1]); w.w = cvt_pk_bf16(v1[2], v1[3]);
                        *(u32x4*)(rowp + (2 * pn + bj) * 192) = w; } }
        } else {
            const int head = (pn - 4) * 4 + wc, i0 = 8 * fq;
#pragma unroll
            for (int ai = 0; ai < 2; ++ai)
#pragma unroll
                for (int m = 0; m < 4; ++m) { const int row = rowb + ai * HALF + m * 16; const float* cp = cs + (size_t)row * 64 + i0;
                    const f32x4 c0 = *(const f32x4*)cp, c1 = *(const f32x4*)(cp + 4), s0 = *(const f32x4*)(cp + 32), s1 = *(const f32x4*)(cp + 36);
                    const f32x4 a0 = acc[ai][0][m][0], a1 = acc[ai][0][m][1], b0 = acc[ai][1][m][0], b1 = acc[ai][1][m][1];
                    const f32x4 o10 = (a0 * c0 - b0 * s0) * MLA_C2, o11 = (a1 * c1 - b1 * s1) * MLA_C2, o20 = (b0 * c0 + a0 * s0) * MLA_C2, o21 = (b1 * c1 + a1 * s1) * MLA_C2;
                    bf16_t* rowp = q + (size_t)row * 1536 + head * 192 + 128 + i0; u32x4 w;
                    w.x = cvt_pk_bf16(o10[0], o10[1]); w.y = cvt_pk_bf16(o10[2], o10[3]); w.z = cvt_pk_bf16(o11[0], o11[1]); w.w = cvt_pk_bf16(o11[2], o11[3]);
                    *(u32x4*)rowp = w;
                    w.x = cvt_pk_bf16(o20[0], o20[1]); w.y = cvt_pk_bf16(o20[2], o20[3]); w.z = cvt_pk_bf16(o21[0], o21[1]); w.w = cvt_pk_bf16(o21[2], o21[3]);
                    *(u32x4*)(rowp + 32) = w; }
        }
    }
};
struct EpiKV {
    static constexpr bool PERM = true, AFTER_DRAIN = false;
    bf16_t* kv;
    __device__ __forceinline__ void operator()(AccRef acc, const Unit& u, int wr, int wc, int fr, int fq) const {
        const int pn = u.pn; store_tile_bf16(acc, kv + (size_t)(pn >> 2) * ((size_t)T * 1024), 1024, u.pm * BM + wr * 64 + fr, (pn & 3) * 256 + wc * 32 + 8 * fq, 1.0f);
    }
};
struct EpiPlain {
    static constexpr bool PERM = true, AFTER_DRAIN = false;
    bf16_t* o; int ld;
    __device__ __forceinline__ void operator()(AccRef acc, const Unit& u, int wr, int wc, int fr, int fq) const {
        store_tile_bf16(acc, o, ld, u.pm * BM + wr * 64 + fr, u.pn * 256 + wc * 32 + 8 * fq, 1.0f);
    }
};
template <bool SECOND> struct EpiGate {
    static constexpr bool PERM = true, AFTER_DRAIN = false;
    const bf16_t* gates; bf16_t* tmp; bf16_t* out;
    __device__ __forceinline__ void operator()(AccRef acc, const Unit& u, int wr, int wc, int fr, int fq) const {
        const int rowb = u.pm * BM + wr * 64 + fr, c0 = u.pn * 256 + wc * 32 + 8 * fq;
#pragma unroll
        for (int ai = 0; ai < 2; ++ai)
#pragma unroll
            for (int m = 0; m < 4; ++m) { const size_t row = (size_t)(rowb + ai * HALF + m * 16);
#pragma unroll
                for (int bj = 0; bj < 2; ++bj) { const int c = c0 + bj * HALF;
                    const u32x4 g = *(const u32x4*)(gates + row * 4096 + (SECOND ? 2048 : 0) + c);
                    const f32x4 a0 = acc[ai][bj][m][0], a1 = acc[ai][bj][m][1];
                    float r[8] = {a0[0] * bflo(g.x), a0[1] * bfhi(g.x), a0[2] * bflo(g.y), a0[3] * bfhi(g.y), a1[0] * bflo(g.z), a1[1] * bfhi(g.z), a1[2] * bflo(g.w), a1[3] * bfhi(g.w)};
                    if (SECOND) { const u32x4 t = *(const u32x4*)(tmp + row * 2048 + c);
                        r[0] += bflo(t.x); r[1] += bfhi(t.x); r[2] += bflo(t.y); r[3] += bfhi(t.y); r[4] += bflo(t.z); r[5] += bfhi(t.z); r[6] += bflo(t.w); r[7] += bfhi(t.w); }
                    u32x4 w; w.x = cvt_pk_bf16(r[0], r[1]); w.y = cvt_pk_bf16(r[2], r[3]); w.z = cvt_pk_bf16(r[4], r[5]); w.w = cvt_pk_bf16(r[6], r[7]);
                    *(u32x4*)((SECOND ? out : tmp) + row * 2048 + c) = w; } }
    }
};
struct EpiSwiglu {
    static constexpr bool PERM = true, AFTER_DRAIN = false;
    bf16_t* act;
    __device__ __forceinline__ void operator()(AccRef acc, const Unit& u, int wr, int wc, int fr, int fq) const {
        const int rowb = u.pm * BM + wr * 64 + fr, c0 = u.pn * 128 + wc * 32 + 8 * fq;
#pragma unroll
        for (int ai = 0; ai < 2; ++ai)
#pragma unroll
            for (int m = 0; m < 4; ++m) { const f32x4 g0 = acc[ai][0][m][0], g1 = acc[ai][0][m][1], u0 = acc[ai][1][m][0], u1 = acc[ai][1][m][1]; float r[8];
#pragma unroll
                for (int k = 0; k < 4; ++k) { r[k] = g0[k] * sigmoidf_(g0[k]) * u0[k]; r[4 + k] = g1[k] * sigmoidf_(g1[k]) * u1[k]; }
                u32x4 w; w.x = cvt_pk_bf16(r[0], r[1]); w.y = cvt_pk_bf16(r[2], r[3]); w.z = cvt_pk_bf16(r[4], r[5]); w.w = cvt_pk_bf16(r[6], r[7]);
                *(u32x4*)(act + (size_t)(rowb + ai * HALF + m * 16) * DFF + c0) = w; }
    }
};
}

namespace att {
constexpr int VSTR = 320, VOFF = 64 * 400, STAGE = VOFF + 64 * VSTR  , FLAG_OFF = 2 * STAGE;
typedef short v4i16_t __attribute__((ext_vector_type(4)));
__device__ __forceinline__ int crow(int r, int hi) { return (r & 3) + 8 * (r >> 2) + 4 * hi; }
__device__ __forceinline__ unsigned cvtpk(float lo, float hi) { typedef float f2 __attribute__((ext_vector_type(2))); typedef __bf16 b2 __attribute__((ext_vector_type(2))); f2 v = {lo, hi}; b2 b = __builtin_convertvector(v, b2); return __builtin_bit_cast(unsigned, b); }
__device__ __forceinline__ s16x4 vtr(const LAS unsigned char* p) { return __builtin_bit_cast(s16x4, __builtin_amdgcn_ds_read_tr16_b64_v4i16((LAS v4i16_t*)p)); }
__device__ __forceinline__ float partner(float x, int hi) { auto rr = __builtin_amdgcn_permlane32_swap(__float_as_uint(x), __float_as_uint(x), false, false); return __uint_as_float(hi ? rr[0] : rr[1]); }

template <bool MLA>
__device__ __forceinline__ void attn_unit(LAS unsigned char* lds, const int b, const int h, const int qb,
        const bf16_t* Q, const bf16_t* __restrict__ K, const bf16_t* __restrict__ KR, const bf16_t* __restrict__ V, bf16_t* O) {
    constexpr int DK = MLA ? 192 : 128, NKS = DK / 16, KSTR = DK * 2 + 16, QP = MLA ? 1536 : 1024;
    const int tid = threadIdx.x, lane = tid & 63, r32 = lane & 31, hi = lane >> 5;
    const int wid = __builtin_amdgcn_readfirstlane(tid >> 6);
    const size_t rowbase = (size_t)b * SEQ;
    const int q0 = qb * 256, NT = 4 * qb + 4, tdiag = 4 * qb + (wid >> 1);
    const int srow = tid >> 4, sch = tid & 15;
    const bf16_t* kg = K + (rowbase + srow) * 1024 + h * 128 + sch * 8;
    const bf16_t* vg = V + (rowbase + srow) * 1024 + h * 128 + sch * 8;
    const bf16_t* rg = KR + (rowbase + (tid >> 3)) * 64 + (tid & 7) * 8;
    const int kdst = srow * KSTR + sch * 16, vdst = VOFF + srow * VSTR + sch * 16, rdst = (tid >> 3) * KSTR + 256 + (tid & 7) * 16;
    u32x4 sk0, sk1, sv0, sv1, sr;
#define ATT_LOAD(tt) do { const size_t o_ = (size_t)(tt) * 65536; sk0 = *(const u32x4*)(kg + o_); sk1 = *(const u32x4*)(kg + o_ + 32768); sv0 = *(const u32x4*)(vg + o_); sv1 = *(const u32x4*)(vg + o_ + 32768); \
        if (MLA) sr = *(const u32x4*)(rg + (size_t)(tt) * 4096); } while (0)
#define ATT_STORE(so) do { *(LAS u32x4*)(lds + (so) + kdst) = sk0; *(LAS u32x4*)(lds + (so) + kdst + 32 * KSTR) = sk1; *(LAS u32x4*)(lds + (so) + vdst) = sv0; *(LAS u32x4*)(lds + (so) + vdst + 32 * VSTR) = sv1; \
        if (MLA) *(LAS u32x4*)(lds + (so) + rdst) = sr; } while (0)
    const int t0 = MLA ? 0 : NT - 1, tstep = MLA ? 1 : -1;
    ATT_LOAD(t0);
    bf16x8 qf[NKS];
    { const bf16_t* qrow = Q + (rowbase + q0 + wid * 32 + r32) * QP + h * DK + hi * 8;
#pragma unroll
      for (int d0 = 0; d0 < NKS; ++d0) qf[d0] = *(const bf16x8*)(qrow + d0 * 16); }
    f32x16 o[4];
#pragma unroll
    for (int i = 0; i < 4; ++i)
#pragma unroll
        for (int r = 0; r < 16; ++r) o[i][r] = 0.f;
    float m_ref = 0.f, lsum = 0.f, R = 0.f;
    const int kfb = r32 * KSTR + hi * 16;
    const int vfb = VOFF + (4 * hi + ((lane & 15) >> 2)) * VSTR + (((lane >> 4) & 1) * 16 + (lane & 3) * 4) * 2;
    volatile LAS unsigned* flags = (volatile LAS unsigned*)(lds + FLAG_OFF);
    ATT_STORE(0);
    if (NT > 1) ATT_LOAD(t0 + tstep);
    __syncthreads();
    int t = t0;
    for (int it = 0; it < NT; ++it, t += tstep) {
        const int st = (it & 1) * STAGE;
        if (it + 1 < NT) ATT_STORE(((it + 1) & 1) * STAGE);
        if (it + 2 < NT) ATT_LOAD(t + 2 * tstep);
        if (MLA) { if (t <= tdiag) {
            f32x16 p0, p1;
#pragma unroll
            for (int r = 0; r < 16; ++r) { p0[r] = -m_ref; p1[r] = -m_ref; }
            __builtin_amdgcn_s_setprio(3);
#pragma unroll
            for (int d0 = 0; d0 < NKS; ++d0) {
                const bf16x8 k0 = *(const LAS bf16x8*)(lds + st + kfb + d0 * 32);
                p0 = __builtin_amdgcn_mfma_f32_32x32x16_bf16(k0, qf[d0], p0, 0, 0, 0);
            }
            if (wid >= 4) __builtin_amdgcn_s_setprio(1); else __builtin_amdgcn_s_setprio(0);
            float tmA = p0[0];
#pragma unroll
            for (int r = 1; r < 16; ++r) tmA = fmaxf(tmA, p0[r]);
            tmA = fmaxf(tmA, partner(tmA, hi));
            float dA = 0.f; bool flagA = false;
            if (it == 0 || __any(tmA > 8.0f)) {
                dA = (it == 0) ? tmA : fmaxf(tmA, 0.f);
                if (it != 0) { const float sc = ex2(-dA); lsum *= sc;
#pragma unroll
                    for (int i = 0; i < 4; ++i)
#pragma unroll
                        for (int r = 0; r < 16; ++r) o[i][r] *= sc; }
                m_ref += dA; flagA = true;
#pragma unroll
                for (int r = 0; r < 16; ++r) p0[r] -= dA;
            }
#pragma unroll
            for (int d0 = 0; d0 < NKS; ++d0) {
                const bf16x8 k1 = *(const LAS bf16x8*)(lds + st + kfb + 32 * KSTR + d0 * 32);
                p1 = __builtin_amdgcn_mfma_f32_32x32x16_bf16(k1, qf[d0], p1, 0, 0, 0);
            }
            { float ps = 0.f;
#pragma unroll
              for (int r = 0; r < 16; ++r) { p0[r] = ex2(p0[r]); ps += p0[r]; }
              lsum += ps; }
            if (flagA) {
#pragma unroll
                for (int r = 0; r < 16; ++r) p1[r] -= dA;
            }
            float tmB = p1[0];
#pragma unroll
            for (int r = 1; r < 16; ++r) tmB = fmaxf(tmB, p1[r]);
            tmB = fmaxf(tmB, partner(tmB, hi));
            if (__any(tmB > 8.0f)) {
                const float dB = fmaxf(tmB, 0.f), sc = ex2(-dB); lsum *= sc; m_ref += dB;
#pragma unroll
                for (int i = 0; i < 4; ++i)
#pragma unroll
                    for (int r = 0; r < 16; ++r) o[i][r] *= sc;
#pragma unroll
                for (int r = 0; r < 16; ++r) { p0[r] *= sc; p1[r] -= dB; }
            }
            bf16x8 pf[4];
            { u32x4 w;
              w.x = cvtpk(p0[0], p0[1]); w.y = cvtpk(p0[2], p0[3]); w.z = cvtpk(p0[4], p0[5]); w.w = cvtpk(p0[6], p0[7]); pf[0] = __builtin_bit_cast(bf16x8, w);
              w.x = cvtpk(p0[8], p0[9]); w.y = cvtpk(p0[10], p0[11]); w.z = cvtpk(p0[12], p0[13]); w.w = cvtpk(p0[14], p0[15]); pf[1] = __builtin_bit_cast(bf16x8, w); }
#pragma unroll
            for (int s = 0; s < 2; ++s)
#pragma unroll
                for (int dt = 0; dt < 4; ++dt) {
                    const s16x4 lo = vtr(lds + st + vfb + s * 16 * VSTR + dt * 64);
                    const s16x4 hh = vtr(lds + st + vfb + s * 16 * VSTR + dt * 64 + 8 * VSTR);
                    const bf16x8 vf = {lo[0], lo[1], lo[2], lo[3], hh[0], hh[1], hh[2], hh[3]};
                    o[dt] = __builtin_amdgcn_mfma_f32_32x32x16_bf16(vf, pf[s], o[dt], 0, 0, 0);
                }
            { float ps = 0.f;
#pragma unroll
              for (int r = 0; r < 16; ++r) { p1[r] = ex2(p1[r]); ps += p1[r]; }
              lsum += ps;
              u32x4 w;
              w.x = cvtpk(p1[0], p1[1]); w.y = cvtpk(p1[2], p1[3]); w.z = cvtpk(p1[4], p1[5]); w.w = cvtpk(p1[6], p1[7]); pf[2] = __builtin_bit_cast(bf16x8, w);
              w.x = cvtpk(p1[8], p1[9]); w.y = cvtpk(p1[10], p1[11]); w.z = cvtpk(p1[12], p1[13]); w.w = cvtpk(p1[14], p1[15]); pf[3] = __builtin_bit_cast(bf16x8, w); }
#pragma unroll
            for (int s = 2; s < 4; ++s)
#pragma unroll
                for (int dt = 0; dt < 4; ++dt) {
                    const s16x4 lo = vtr(lds + st + vfb + s * 16 * VSTR + dt * 64);
                    const s16x4 hh = vtr(lds + st + vfb + s * 16 * VSTR + dt * 64 + 8 * VSTR);
                    const bf16x8 vf = {lo[0], lo[1], lo[2], lo[3], hh[0], hh[1], hh[2], hh[3]};
                    o[dt] = __builtin_amdgcn_mfma_f32_32x32x16_bf16(vf, pf[s], o[dt], 0, 0, 0);
                }
        } } else
        if (t <= tdiag) {
            f32x16 p0, p1;
#pragma unroll
            for (int r = 0; r < 16; ++r) { p0[r] = 0.f; p1[r] = 0.f; }
#pragma unroll
            for (int d0 = 0; d0 < NKS; ++d0) {
                const bf16x8 k0 = *(const LAS bf16x8*)(lds + st + kfb + d0 * 32);
                const bf16x8 k1 = *(const LAS bf16x8*)(lds + st + kfb + 32 * KSTR + d0 * 32);
                p0 = __builtin_amdgcn_mfma_f32_32x32x16_bf16(k0, qf[d0], p0, 0, 0, 0);
                p1 = __builtin_amdgcn_mfma_f32_32x32x16_bf16(k1, qf[d0], p1, 0, 0, 0);
            }
            if (MLA) {
                float tm = fmaxf(p0[0], p1[0]);
#pragma unroll
                for (int r = 1; r < 16; ++r) tm = fmaxf(tm, fmaxf(p0[r], p1[r]));
                tm = fmaxf(tm, partner(tm, hi));
                if (__any(tm > m_ref + 8.0f)) {
                    const float mn = fmaxf(m_ref, tm), sc = ex2(m_ref - mn);
                    lsum *= sc;
#pragma unroll
                    for (int i = 0; i < 4; ++i)
#pragma unroll
                        for (int r = 0; r < 16; ++r) o[i][r] *= sc;
                    m_ref = mn;
                }
                float ps = 0.f;
#pragma unroll
                for (int r = 0; r < 16; ++r) { p0[r] = ex2(p0[r] - m_ref); p1[r] = ex2(p1[r] - m_ref); ps += p0[r] + p1[r]; }
                lsum += ps;
            } else {
                const bool diag = (t == tdiag);
                const int qrel = (wid & 1) * 32 + r32;
                float lk[32];
#pragma unroll
                for (int x = 0; x < 32; ++x) {
                    const float z = x < 16 ? p0[x] : p1[x - 16];
                    const int kv = (x < 16 ? 0 : 32) + crow(x & 15, hi);
                    const bool valid = !diag || kv < qrel;
                    const float e = ex2(-fabsf(z) * LOG2E);
                    const float sp = fmaxf(z, 0.f) + LN2 * __builtin_amdgcn_logf(1.0f + e);
                    lk[x] = valid ? -sp : 0.f;
                }
                float gs[8], ot[8], ST[8];
#pragma unroll
                for (int k = 0; k < 8; ++k) { gs[k] = (lk[4 * k] + lk[4 * k + 1]) + (lk[4 * k + 2] + lk[4 * k + 3]); ot[k] = partner(gs[k], hi); }
                ST[7] = 0.f;
#pragma unroll
                for (int k = 6; k >= 0; --k) ST[k] = ST[k + 1] + (gs[k + 1] + ot[k + 1]);
                const float tot = ST[0] + (gs[0] + ot[0]);
#pragma unroll
                for (int k = 0; k < 8; ++k) {
                    const float s3 = R + ST[k] + (hi == 0 ? ot[k] : 0.f);
                    const float s2 = s3 + lk[4 * k + 3], s1 = s2 + lk[4 * k + 2], s0 = s1 + lk[4 * k + 1];
                    const float ss[4] = {s0, s1, s2, s3};
#pragma unroll
                    for (int i = 0; i < 4; ++i) {
                        const int x = 4 * k + i;
                        const float z = x < 16 ? p0[x] : p1[x - 16];
                        const int kv = (x < 16 ? 0 : 32) + crow(x & 15, hi);
                        const bool valid = !diag || kv < qrel;
                        const float w = valid ? ex2((z + lk[x] + ss[i]) * LOG2E) : 0.f;
                        if (x < 16) p0[x] = w; else p1[x - 16] = w;
                    }
                }
                R += tot;
            }
            bf16x8 pf[4];
            { u32x4 w;
              w.x = cvtpk(p0[0], p0[1]); w.y = cvtpk(p0[2], p0[3]); w.z = cvtpk(p0[4], p0[5]); w.w = cvtpk(p0[6], p0[7]); pf[0] = __builtin_bit_cast(bf16x8, w);
              w.x = cvtpk(p0[8], p0[9]); w.y = cvtpk(p0[10], p0[11]); w.z = cvtpk(p0[12], p0[13]); w.w = cvtpk(p0[14], p0[15]); pf[1] = __builtin_bit_cast(bf16x8, w);
              w.x = cvtpk(p1[0], p1[1]); w.y = cvtpk(p1[2], p1[3]); w.z = cvtpk(p1[4], p1[5]); w.w = cvtpk(p1[6], p1[7]); pf[2] = __builtin_bit_cast(bf16x8, w);
              w.x = cvtpk(p1[8], p1[9]); w.y = cvtpk(p1[10], p1[11]); w.z = cvtpk(p1[12], p1[13]); w.w = cvtpk(p1[14], p1[15]); pf[3] = __builtin_bit_cast(bf16x8, w); }
#pragma unroll
            for (int s = 0; s < 4; ++s)
#pragma unroll
                for (int dt = 0; dt < 4; ++dt) {
                    const s16x4 lo = vtr(lds + st + vfb + s * 16 * VSTR + dt * 64);
                    const s16x4 hh = vtr(lds + st + vfb + s * 16 * VSTR + dt * 64 + 8 * VSTR);
                    const bf16x8 vf = {lo[0], lo[1], lo[2], lo[3], hh[0], hh[1], hh[2], hh[3]};
                    o[dt] = __builtin_amdgcn_mfma_f32_32x32x16_bf16(vf, pf[s], o[dt], 0, 0, 0);
                }
        }
        if (!MLA) { const bool dn = __all(R <= SB_EXIT); if (lane == 0) flags[(it & 1) * 8 + wid] = dn ? 1u : 0u; }
        __syncthreads();
        if (!MLA) { unsigned a = 1u;
#pragma unroll
            for (int w = 0; w < 8; ++w) a &= flags[(it & 1) * 8 + w];
            if (a) break; }
    }
#undef ATT_LOAD
#undef ATT_STORE
    float inv = 1.0f;
    if (MLA) inv = __builtin_amdgcn_rcpf(lsum + partner(lsum, hi));
    bf16_t* orow = O + (rowbase + q0 + wid * 32 + r32) * 1024 + h * 128 + 4 * hi;
#pragma unroll
    for (int dt = 0; dt < 4; ++dt)
#pragma unroll
        for (int g = 0; g < 4; ++g) { u32x2 w; w.x = cvtpk(o[dt][4 * g] * inv, o[dt][4 * g + 1] * inv); w.y = cvtpk(o[dt][4 * g + 2] * inv, o[dt][4 * g + 3] * inv);
            *(u32x2*)(orow + dt * 32 + 8 * g) = w; }
}
}

#define XB_TMO      128
#define XB_XCNT(j)  (256  + 64 * (j))
#define XB_XSUB(j)  (1280 + 64 * (j))
#define XB_XGEN(j)  (2304 + 64 * (j))
#define XB_TOP      3328
#define XB_TOPGEN   3392
#define XCD_BAR_WORDS 3456
#define XB_SPIN_CAP (1u << 18)

__device__ __forceinline__ unsigned xb_ld(unsigned* p)              { return __hip_atomic_load(p, __ATOMIC_RELAXED, __HIP_MEMORY_SCOPE_AGENT); }
__device__ __forceinline__ unsigned xb_add(unsigned* p, unsigned v) { return __hip_atomic_fetch_add(p, v, __ATOMIC_RELAXED, __HIP_MEMORY_SCOPE_AGENT); }
__device__ __forceinline__ unsigned xb_xcc_id() { return (unsigned)__builtin_amdgcn_s_getreg((3 << 11) | 20) & 0xFu; }
#define XB_SPIN(cond, bar) do { unsigned _sp = 0; while (cond) { __builtin_amdgcn_s_sleep(1); \
    if ((++_sp & 255u) == 0u) { if (xb_ld(&(bar)[XB_TMO])) break; if (_sp > XB_SPIN_CAP) { atomicAdd(&(bar)[XB_TMO], 1u); break; } } } } while (0)

struct XcdBarrier {
    unsigned* bar; unsigned x;
    volatile LAS unsigned* st;
};

__device__ __forceinline__ XcdBarrier xcd_barrier_post(unsigned* bar, volatile LAS unsigned* st) {
    XcdBarrier b; b.bar = bar; b.x = xb_xcc_id(); b.st = st;
    if (threadIdx.x == 0) (void)xb_add(&bar[XB_XCNT(b.x)], 1u);
    return b;
}
__device__ __forceinline__ void xcd_barrier_complete(unsigned* bar, unsigned x, unsigned& nloc, unsigned& nx) {
    const unsigned G = gridDim.x * gridDim.y * gridDim.z;
    unsigned sum, cnt, mine, sp = 0u;
    for (;;) {
        sum = 0u; cnt = 0u; mine = 0u;
#pragma unroll
        for (unsigned j = 0; j < 16; ++j) { const unsigned c = xb_ld(&bar[XB_XCNT(j)]); sum += c; cnt += (c > 0u) ? 1u : 0u; mine = (j == x) ? c : mine; }
        if (sum == G) break;
        __builtin_amdgcn_s_sleep(1);
        if ((++sp & 255u) == 0u) { if (xb_ld(&bar[XB_TMO])) break; if (sp > XB_SPIN_CAP) { atomicAdd(&bar[XB_TMO], 1u); break; } }
    }
    nloc = mine > 0u ? mine : 1u; nx = cnt > 0u ? cnt : 1u;
}

__device__ __forceinline__ void xcd_barrier(const XcdBarrier& b) {
    asm volatile("s_waitcnt vmcnt(0)" ::: "memory");
    __syncthreads();
    if (threadIdx.x == 0) {
        unsigned* bar = b.bar;
        __builtin_amdgcn_s_waitcnt(0);
        unsigned nloc = b.st[0], nx = b.st[1];
        if (nloc == 0u) { xcd_barrier_complete(bar, b.x, nloc, nx); b.st[0] = nloc; b.st[1] = nx; }
        const unsigned old = xb_add(&bar[XB_XSUB(b.x)], 1u);
        const unsigned gen = old / nloc;
        if (old + 1u == (gen + 1u) * nloc) {
            __builtin_amdgcn_fence(__ATOMIC_RELEASE, "agent");
            asm volatile("s_waitcnt vmcnt(0)" ::: "memory");
            const unsigned og = xb_add(&bar[XB_TOP], 1u);
            const unsigned tg = og / nx;
            if (og + 1u == (tg + 1u) * nx) xb_add(&bar[XB_TOPGEN], 1u);
            else XB_SPIN(xb_ld(&bar[XB_TOPGEN]) == tg, bar);
            __builtin_amdgcn_fence(__ATOMIC_ACQUIRE, "agent");
            xb_add(&bar[XB_XGEN(b.x)], 1u);
            asm volatile("s_waitcnt vmcnt(0)" ::: "memory");
        } else {
            XB_SPIN(xb_ld(&bar[XB_XGEN(b.x)]) == gen, bar);
            __builtin_amdgcn_fence(__ATOMIC_ACQUIRE, "agent");
            asm volatile("s_waitcnt vmcnt(0)" ::: "memory");
        }
    }
    __syncthreads();
}


#include <hip/hip_cooperative_groups.h>
namespace cg = cooperative_groups;
#ifndef MK_COOP
#define MK_COOP 1
#endif
constexpr int NPH = 12;
constexpr int RBH = 2;
constexpr int RB = 4;
struct Args { const float* in[17]; float* out; unsigned char* ws; float invf[32]; int ph_lo, ph_hi; };
static_assert(sizeof(Args) == 17 * 8 + 16 + 128 + 8, "Args has no padding");


__device__ __forceinline__ void unpack8(const u32x4 w, float* v) { v[0] = bflo(w.x); v[1] = bfhi(w.x); v[2] = bflo(w.y); v[3] = bfhi(w.y); v[4] = bflo(w.z); v[5] = bfhi(w.z); v[6] = bflo(w.w); v[7] = bfhi(w.w); }
__device__ __forceinline__ void rowU_load(const float* x, int m, int lane, f32x4 (&v)[8]) {
    const f32x4* xr = (const f32x4*)(x + (size_t)m * DM) + lane;
#pragma unroll
    for (int j = 0; j < 8; ++j) v[j] = xr[64 * j];
}
__device__ __forceinline__ void rowU_finish(const f32x4 (&v)[8], const float* g, bf16_t* U, int m, int lane) {
    float s = 0.f;
#pragma unroll
    for (int j = 0; j < 8; ++j) s += (v[j].x * v[j].x + v[j].y * v[j].y) + (v[j].z * v[j].z + v[j].w * v[j].w);
    const float rstd = 1.0f / sqrtf(wave_sum(s) * (1.0f / DM) + EPS);
    u32x2* o8 = (u32x2*)(U + (size_t)m * DM) + lane;
#pragma unroll
    for (int j = 0; j < 8; ++j) { const f32x4 gg = *((const f32x4*)g + lane + 64 * j); u32x2 w; w.x = pk2(v[j].x * rstd * gg.x, v[j].y * rstd * gg.y); w.y = pk2(v[j].z * rstd * gg.z, v[j].w * rstd * gg.w); o8[64 * j] = w; }
}
__device__ __forceinline__ void rowH_load(const bf16_t* mixed, const float* x, int m, int lane, u32x4 (&mw)[4], f32x4 (&xx)[8]) {
    const u32x4* mp = (const u32x4*)(mixed + (size_t)m * DM) + lane; const f32x4* xr = (const f32x4*)(x + (size_t)m * DM);
#pragma unroll
    for (int j = 0; j < 4; ++j) { mw[j] = mp[64 * j]; xx[2 * j] = xr[(lane + 64 * j) * 2]; xx[2 * j + 1] = xr[(lane + 64 * j) * 2 + 1]; }
}
__device__ __forceinline__ void rowH_finish(const u32x4 (&mw)[4], const f32x4 (&xx)[8], const float* g1, const float* g2, bf16_t* h1, bf16_t* U, int m, int lane) {
    float v[32]; float s = 0.f;
#pragma unroll
    for (int j = 0; j < 4; ++j) unpack8(mw[j], v + 8 * j);
#pragma unroll
    for (int e = 0; e < 32; ++e) s += v[e] * v[e];
    const float rstd = 1.0f / sqrtf(wave_sum(s) * (1.0f / DM) + EPS); float s2 = 0.f;
#pragma unroll
    for (int j = 0; j < 4; ++j) {
#pragma unroll
        for (int q = 0; q < 2; ++q) { const int c4 = (lane + 64 * j) * 2 + q; const f32x4 x4 = xx[2 * j + q], gg = ((const f32x4*)g1)[c4];
            v[8 * j + 4 * q] = x4.x + v[8 * j + 4 * q] * rstd * gg.x; v[8 * j + 4 * q + 1] = x4.y + v[8 * j + 4 * q + 1] * rstd * gg.y;
            v[8 * j + 4 * q + 2] = x4.z + v[8 * j + 4 * q + 2] * rstd * gg.z; v[8 * j + 4 * q + 3] = x4.w + v[8 * j + 4 * q + 3] * rstd * gg.w; }
    }
#pragma unroll
    for (int e = 0; e < 32; ++e) s2 += v[e] * v[e];
    const float rstd2 = 1.0f / sqrtf(wave_sum(s2) * (1.0f / DM) + EPS);
    u32x4* hp = (u32x4*)(h1 + (size_t)m * DM) + lane; u32x4* up = (u32x4*)(U + (size_t)m * DM) + lane;
#pragma unroll
    for (int j = 0; j < 4; ++j) { const int c4 = (lane + 64 * j) * 2; const f32x4 ga = ((const f32x4*)g2)[c4], gb = ((const f32x4*)g2)[c4 + 1]; u32x4 w;
        w.x = pk2(v[8 * j], v[8 * j + 1]); w.y = pk2(v[8 * j + 2], v[8 * j + 3]); w.z = pk2(v[8 * j + 4], v[8 * j + 5]); w.w = pk2(v[8 * j + 6], v[8 * j + 7]); hp[64 * j] = w;
        w.x = pk2(v[8 * j] * rstd2 * ga.x, v[8 * j + 1] * rstd2 * ga.y); w.y = pk2(v[8 * j + 2] * rstd2 * ga.z, v[8 * j + 3] * rstd2 * ga.w);
        w.z = pk2(v[8 * j + 4] * rstd2 * gb.x, v[8 * j + 5] * rstd2 * gb.y); w.w = pk2(v[8 * j + 6] * rstd2 * gb.z, v[8 * j + 7] * rstd2 * gb.w); up[64 * j] = w; }
}
__device__ __forceinline__ void rowO_load(const bf16_t* down, const bf16_t* h1, int m, int lane, u32x4 (&dw)[4], u32x4 (&hw)[4]) {
    const u32x4* dp = (const u32x4*)(down + (size_t)m * DM) + lane; const u32x4* hp = (const u32x4*)(h1 + (size_t)m * DM) + lane;
#pragma unroll
    for (int j = 0; j < 4; ++j) { dw[j] = dp[64 * j]; hw[j] = hp[64 * j]; }
}
__device__ __forceinline__ void rowO_finish(const u32x4 (&dw)[4], const u32x4 (&hw)[4], const float* g3, float* out, int m, int lane) {
    float v[32], h[32]; float s = 0.f;
#pragma unroll
    for (int j = 0; j < 4; ++j) { unpack8(dw[j], v + 8 * j); unpack8(hw[j], h + 8 * j); }
#pragma unroll
    for (int e = 0; e < 32; ++e) s += v[e] * v[e];
    const float rstd = 1.0f / sqrtf(wave_sum(s) * (1.0f / DM) + EPS);
    f32x4* op = (f32x4*)(out + (size_t)m * DM);
#pragma unroll
    for (int j = 0; j < 4; ++j)
#pragma unroll
        for (int q = 0; q < 2; ++q) { const int c4 = (lane + 64 * j) * 2 + q; const f32x4 gg = ((const f32x4*)g3)[c4]; f32x4 o;
            o.x = h[8 * j + 4 * q] + v[8 * j + 4 * q] * rstd * gg.x; o.y = h[8 * j + 4 * q + 1] + v[8 * j + 4 * q + 1] * rstd * gg.y;
            o.z = h[8 * j + 4 * q + 2] + v[8 * j + 4 * q + 2] * rstd * gg.z; o.w = h[8 * j + 4 * q + 3] + v[8 * j + 4 * q + 3] * rstd * gg.w; op[c4] = o; }
}

__device__ __forceinline__ void transpose_item(const float* __restrict__ W, int K, int N, bf16_t* __restrict__ WT, int k0, int n0, int drow, LAS float* scr, int lane) {
    float tv[32];
#pragma unroll
    for (int i = 0; i < 32; ++i) { const int kk = 2 * i + (lane >> 5); tv[i] = W[(size_t)(k0 + kk) * N + n0 + (lane & 31)]; }
#pragma unroll
    for (int i = 0; i < 32; ++i) { const int kk = 2 * i + (lane >> 5); scr[kk * 33 + (lane & 31)] = tv[i]; }
    asm volatile("s_waitcnt lgkmcnt(0)" ::: "memory");
    const int c = lane & 7;
#pragma unroll
    for (int j = 0; j < 4; ++j) { const int n = (lane >> 3) + 8 * j; const LAS float* s = scr + (8 * c) * 33 + n;
        u32x4 o; o.x = pk2(s[0 * 33], s[1 * 33]); o.y = pk2(s[2 * 33], s[3 * 33]); o.z = pk2(s[4 * 33], s[5 * 33]); o.w = pk2(s[6 * 33], s[7 * 33]);
        *(u32x4*)(WT + (size_t)(drow + n) * K + k0 + 8 * c) = o; }
    asm volatile("s_waitcnt lgkmcnt(0)" ::: "memory");
}
__device__ __forceinline__ int dst_row(int id, int n0) {
    switch (id) {
    case 0: return n0 < 4352 ? n0 : (n0 < 4416 ? 8448 + (n0 - 4352) : 4352 + (n0 - 4416));
    case 1: { const int h = n0 / 192, j = n0 % 192; return j < 128 ? h * 128 + j : 1024 + (h >> 2) * 256 + (j >= 160 ? 128 : 0) + (h & 3) * 32; }
    case 2: { const int h = n0 >> 8, j = n0 & 255; return j < 128 ? h * 128 + j : 1024 + h * 128 + (j - 128); }
    case 6: { const int up = n0 >= DFF, j = up ? n0 - DFF : n0; return (j >> 7) * 256 + (up ? 128 : 0) + (j & 127); }
    default: return n0;
    }
}

__global__ void __launch_bounds__(512) mk_fwd(Args args) {
    __builtin_assume(__builtin_amdgcn_workitem_id_y() == 0); __builtin_assume(__builtin_amdgcn_workitem_id_z() == 0);
    extern __shared__ __attribute__((aligned(16))) unsigned char lds_raw[];
    LAS unsigned char* lds = (LAS unsigned char*)lds_raw;
    cg::grid_group grid = cg::this_grid();
    const int wave = __builtin_amdgcn_readfirstlane(threadIdx.x >> 6);
    const int G = gridDim.x, bx = blockIdx.x;
    const int vcu = (G % 8 == 0) ? (bx % 8) * (G / 8) + bx / 8 : bx;
    const int gw = vcu * 8 + wave, NGW = G * 8;
    unsigned char* ws = args.ws;
    const int lo = args.ph_lo, hi_ = args.ph_hi;
    volatile LAS unsigned* bst = (volatile LAS unsigned*)(lds + XB_LDS_OFF);
    if (threadIdx.x < 2) bst[threadIdx.x] = 0u;
    __syncthreads();
    XcdBarrier xbar = xcd_barrier_post((unsigned*)ws + XB_WS_WORD, bst);
#define IN(k) (lo <= (k) && (k) < hi_)
#define SEAM(k) do { if (IN(k) && IN((k) + 1)) { if ((k) == 0) grid.sync(); else xcd_barrier(xbar); } } while (0)
    bf16_t* U = (bf16_t*)(ws + A_U);
    bf16_t* gates = (bf16_t*)(ws + A_GATES);
    bf16_t* h1 = (bf16_t*)(ws + A_GATES);

    if (IN(0)) {
        const int lane = lane_id();
        LAS float* scr = (LAS float*)(lds + wave * 16384);
        int base = 0;
#define CONV(id, Wp, Kk, Nn, Off) do { const int nblk = (Nn) / 32, items = ((Kk) / 64) * nblk; \
            for (int it = gw - base; it < items; it += NGW) { if (it < 0) continue; \
                const int kb = it / nblk, nb = it % nblk; transpose_item((Wp), (Kk), (Nn), (bf16_t*)(ws + (Off)), 64 * kb, 32 * nb, dst_row((id), 32 * nb), scr, lane); } \
            base = (base + items) % NGW; } while (0)
        CONV(0, args.in[3], 2048, 8512, W_IN); CONV(1, args.in[6], 768, 1536, W_UQ); CONV(2, args.in[8], 512, 2048, W_UKV); CONV(3, args.in[9], 1024, 2048, W_OSB);
        CONV(4, args.in[10], 1024, 2048, W_OMLA); CONV(5, args.in[11], 2048, 2048, W_OUT); CONV(6, args.in[14], 2048, 2 * DFF, W_GU); CONV(7, args.in[15], DFF, 2048, W_DN);
#undef CONV
        const float* g = args.in[2];
        for (int m = gw; m < T; m += RB * NGW) { f32x4 va[RB][8];
#pragma unroll
            for (int b = 0; b < RB; ++b) { const int mb = m + b * NGW; rowU_load(args.in[0], mb < T ? mb : m, lane, va[b]); }
#pragma unroll
            for (int b = 0; b < RB; ++b) { const int mb = m + b * NGW; if (mb < T) rowU_finish(va[b], g, U, mb, lane); } }
    }
    SEAM(0);
    if (IN(1)) {
        pg8::Gemm g{U, (const bf16_t*)(ws + W_IN), T, N1, 2048}; pg8::StaticOrder S; S.init(T, N1, G, bx);
        pg8::Epi1 E{(bf16_t*)(ws + A_QSB), (bf16_t*)(ws + A_QLAT), (bf16_t*)(ws + A_KVLAT), gates, (float*)(ws + A_KR), args.in[4]};
        pg8::gemm_phase<pg8::Epi1, pg8::StaticOrder, true, true>(lds, g, S, E);
    }
    SEAM(1);
    if (IN(2)) {
        const int lane = lane_id();
        const float* gq = args.in[5]; const float* gkv = args.in[7]; const int* pos = (const int*)args.in[1];
        const int i = lane & 31; const float invf = args.invf[i];
        for (int m = gw; m < T; m += RB * NGW) {
            u32x2 wq[RB][3], wk[RB][2]; float x1[RB], x2[RB], pf[RB];
#pragma unroll
            for (int b = 0; b < RB; ++b) { const int mb = (m + b * NGW < T) ? m + b * NGW : m;
                const u32x2* p = (const u32x2*)(ws + A_QLAT + (size_t)mb * 768 * 2) + lane; const u32x2* p2 = (const u32x2*)(ws + A_KVLAT + (size_t)mb * 512 * 2) + lane;
#pragma unroll
                for (int j = 0; j < 3; ++j) wq[b][j] = p[64 * j];
#pragma unroll
                for (int j = 0; j < 2; ++j) wk[b][j] = p2[64 * j];
                const float* kr = (const float*)(ws + A_KR) + (size_t)mb * 64; x1[b] = kr[i]; x2[b] = kr[i + 32]; pf[b] = (float)pos[mb]; }
#pragma unroll
            for (int b = 0; b < RB; ++b) { const int mb = m + b * NGW; if (mb < T) {
                { u32x2* p = (u32x2*)(ws + A_QLAT + (size_t)mb * 768 * 2) + lane; float s = 0.f;
#pragma unroll
                  for (int j = 0; j < 3; ++j) { const float a = bflo(wq[b][j].x), bb = bfhi(wq[b][j].x), c = bflo(wq[b][j].y), d = bfhi(wq[b][j].y); s += (a * a + bb * bb) + (c * c + d * d); }
                  const float rstd = 1.0f / sqrtf(wave_sum(s) * (1.0f / 768.0f) + EPS);
#pragma unroll
                  for (int j = 0; j < 3; ++j) { const f32x4 gg = *((const f32x4*)gq + lane + 64 * j); u32x2 o; o.x = pk2(bflo(wq[b][j].x) * rstd * gg.x, bfhi(wq[b][j].x) * rstd * gg.y); o.y = pk2(bflo(wq[b][j].y) * rstd * gg.z, bfhi(wq[b][j].y) * rstd * gg.w); p[64 * j] = o; } }
                { u32x2* p = (u32x2*)(ws + A_KVLAT + (size_t)mb * 512 * 2) + lane; float s = 0.f;
#pragma unroll
                  for (int j = 0; j < 2; ++j) { const float a = bflo(wk[b][j].x), bb = bfhi(wk[b][j].x), c = bflo(wk[b][j].y), d = bfhi(wk[b][j].y); s += (a * a + bb * bb) + (c * c + d * d); }
                  const float rstd = 1.0f / sqrtf(wave_sum(s) * (1.0f / 512.0f) + EPS);
#pragma unroll
                  for (int j = 0; j < 2; ++j) { const f32x4 gg = *((const f32x4*)gkv + lane + 64 * j); u32x2 o; o.x = pk2(bflo(wk[b][j].x) * rstd * gg.x, bfhi(wk[b][j].x) * rstd * gg.y); o.y = pk2(bflo(wk[b][j].y) * rstd * gg.z, bfhi(wk[b][j].y) * rstd * gg.w); p[64 * j] = o; } }
                { const float ang = pf[b] * invf;
                  double rev = (double)ang * 0.15915494309189535; rev -= floor(rev); const float rf = (float)rev;
                  const float sn = __builtin_amdgcn_sinf(rf), cn = __builtin_amdgcn_cosf(rf);
                  float* cs = (float*)(ws + A_CS) + (size_t)mb * 64; bf16_t* ko = (bf16_t*)(ws + A_KROPE) + (size_t)mb * 64;
                  if (lane < 32) { cs[i] = cn; ko[i] = (bf16_t)f2bf(x1[b] * cn - x2[b] * sn); } else { cs[32 + i] = sn; ko[32 + i] = (bf16_t)f2bf(x2[b] * cn + x1[b] * sn); } }
            } }
        }
    }
    SEAM(2);
    if (IN(3)) {
        { pg8::Gemm g{(const bf16_t*)(ws + A_QLAT), (const bf16_t*)(ws + W_UQ), T, 1536, 768}; pg8::StaticOrder S; S.init(T, 1536, G, bx);
          pg8::EpiQ E{(bf16_t*)(ws + A_Q), (const float*)(ws + A_CS)}; pg8::gemm_phase<pg8::EpiQ, pg8::StaticOrder, true, true>(lds, g, S, E); }
        { pg8::Gemm g{(const bf16_t*)(ws + A_KVLAT), (const bf16_t*)(ws + W_UKV), T, 2048, 512}; pg8::StaticOrder S; S.init(T, 2048, G, bx);
          pg8::EpiKV E{(bf16_t*)(ws + A_KN)}; pg8::gemm_phase<pg8::EpiKV, pg8::StaticOrder, true, true>(lds, g, S, E); }
    }
    SEAM(3);
    if (IN(4)) {
        if (wave >= 4) __builtin_amdgcn_s_setprio(1);
        const int nvc = (G % 16 == 0) ? G / 16 : 0;
        if (nvc) {
            const int bh = vcu / nvc, s = vcu % nvc, npb = 64 / nvc;
            for (int i = npb - 1; i >= 0; --i) { const int pr = (i >> 1) * nvc + s, qb = (i & 1) ? 63 - pr : pr;
                att::attn_unit<true>(lds, bh >> 3, bh & 7, qb, (const bf16_t*)(ws + A_Q), (const bf16_t*)(ws + A_KN), (const bf16_t*)(ws + A_KROPE), (const bf16_t*)(ws + A_VM), (bf16_t*)(ws + A_MLAO)); }
            for (int i = 0; i < npb; ++i) { const int qb = i * nvc + s;
                att::attn_unit<false>(lds, bh >> 3, bh & 7, qb, (const bf16_t*)(ws + A_QSB), (const bf16_t*)(ws + A_KSB), nullptr, (const bf16_t*)(ws + A_VSB), (bf16_t*)(ws + A_SBO)); }
        } else {
            for (int u = bx; u < 1024; u += G) { const int bh = u >> 6, qb = 63 - (u & 63);
                att::attn_unit<true>(lds, bh >> 3, bh & 7, qb, (const bf16_t*)(ws + A_Q), (const bf16_t*)(ws + A_KN), (const bf16_t*)(ws + A_KROPE), (const bf16_t*)(ws + A_VM), (bf16_t*)(ws + A_MLAO));
                att::attn_unit<false>(lds, bh >> 3, bh & 7, qb, (const bf16_t*)(ws + A_QSB), (const bf16_t*)(ws + A_KSB), nullptr, (const bf16_t*)(ws + A_VSB), (bf16_t*)(ws + A_SBO)); }
        }
    }
    if (IN(4)) __builtin_amdgcn_s_setprio(0);
    SEAM(4);
    if (IN(5)) {
        { pg8::Gemm g{(const bf16_t*)(ws + A_SBO), (const bf16_t*)(ws + W_OSB), T, 2048, 1024}; pg8::StaticOrder S; S.init(T, 2048, G, bx);
          pg8::EpiGate<false> E{gates, (bf16_t*)(ws + A_TMP), U}; pg8::gemm_phase<pg8::EpiGate<false>, pg8::StaticOrder, true, true>(lds, g, S, E); }
    }
    if (IN(6)) {
        { pg8::Gemm g{(const bf16_t*)(ws + A_MLAO), (const bf16_t*)(ws + W_OMLA), T, 2048, 1024}; pg8::StaticOrder S; S.init(T, 2048, G, bx);
          pg8::EpiGate<true> E{gates, (bf16_t*)(ws + A_TMP), U}; pg8::gemm_phase<pg8::EpiGate<true>, pg8::StaticOrder, true, true>(lds, g, S, E); }
    }
    SEAM(6);
    if (IN(7)) {
        pg8::Gemm g{U, (const bf16_t*)(ws + W_OUT), T, 2048, 2048}; pg8::StaticOrder S; S.init(T, 2048, G, bx);
        pg8::EpiPlain E{(bf16_t*)(ws + A_MIXED), 2048}; pg8::gemm_phase<pg8::EpiPlain, pg8::StaticOrder, true, true>(lds, g, S, E);
    }
    SEAM(7);
    if (IN(8)) {
        const int lane = lane_id();
        const float* g1 = args.in[12]; const float* g2 = args.in[13]; const bf16_t* mixed = (const bf16_t*)(ws + A_MIXED);
        for (int m = gw; m < T; m += RBH * NGW) { u32x4 ma[RBH][4]; f32x4 xa[RBH][8];
#pragma unroll
            for (int b = 0; b < RBH; ++b) { const int mb = m + b * NGW; rowH_load(mixed, args.in[0], mb < T ? mb : m, lane, ma[b], xa[b]); }
#pragma unroll
            for (int b = 0; b < RBH; ++b) { const int mb = m + b * NGW; if (mb < T) rowH_finish(ma[b], xa[b], g1, g2, h1, U, mb, lane); } }
    }
    SEAM(8);
    if (IN(9)) {
        pg8::Gemm g{U, (const bf16_t*)(ws + W_GU), T, 2 * DFF, 2048}; pg8::StaticOrder S; S.init(T, 2 * DFF, G, bx);
        pg8::EpiSwiglu E{(bf16_t*)(ws + A_ACT)}; pg8::gemm_phase<pg8::EpiSwiglu, pg8::StaticOrder, true, true>(lds, g, S, E);
    }
    SEAM(9);
    if (IN(10)) {
        pg8::Gemm g{(const bf16_t*)(ws + A_ACT), (const bf16_t*)(ws + W_DN), T, 2048, DFF}; pg8::StaticOrder S; S.init(T, 2048, G, bx);
        pg8::EpiPlain E{U, 2048}; pg8::gemm_phase<pg8::EpiPlain, pg8::StaticOrder, true, true>(lds, g, S, E);
    }
    SEAM(10);
    if (IN(11)) {
        const int lane = lane_id();
        const float* g3 = args.in[16];
        for (int m = gw; m < T; m += RB * NGW) { u32x4 da[RB][4], ha[RB][4];
#pragma unroll
            for (int b = 0; b < RB; ++b) { const int mb = m + b * NGW; rowO_load(U, h1, mb < T ? mb : m, lane, da[b], ha[b]); }
#pragma unroll
            for (int b = 0; b < RB; ++b) { const int mb = m + b * NGW; if (mb < T) rowO_finish(da[b], ha[b], g3, args.out, mb, lane); } }
    }
#undef IN
#undef SEAM
}

extern "C" void kernel_launch(void* const* d_in, const int* in_sizes, int n_in, void* d_out, int out_size, void* d_ws, size_t ws_size, hipStream_t stream) {
    static int grid = 0;
    if (grid == 0) {
        if (n_in != 17 || out_size != T * DM || ws_size < WS_NEED) { fprintf(stderr, "kernel_launch: unexpected shapes (n_in %d out %d ws %zu)\n", n_in, out_size, ws_size); grid = -1; return; }
        int dev = 0, cus = 0, per_cu = 0;
        hipGetDevice(&dev); hipDeviceGetAttribute(&cus, hipDeviceAttributeMultiprocessorCount, dev);
        hipFuncSetAttribute((const void*)mk_fwd, hipFuncAttributeMaxDynamicSharedMemorySize, LDS_BYTES);
        hipOccupancyMaxActiveBlocksPerMultiprocessor(&per_cu, (const void*)mk_fwd, 512, LDS_BYTES);
        (void)hipGetLastError();
        if (per_cu < 1) per_cu = 1;
        grid = cus;
    }
    if (grid < 0) return;
    (void)hipMemsetAsync(d_ws, 0, 65536, stream);
    Args a{};
    for (int i = 0; i < 17; ++i) a.in[i] = (const float*)d_in[i];
    a.out = (float*)d_out; a.ws = (unsigned char*)d_ws;
    for (int i = 0; i < 32; ++i) a.invf[i] = (float)pow(10000.0, -(double)i / 32.0);
#if MK_COOP
    a.ph_lo = 0; a.ph_hi = NPH;
    void* kargs[] = {&a};
    hipError_t e = hipLaunchCooperativeKernel((const void*)mk_fwd, dim3(grid), dim3(512), kargs, LDS_BYTES, stream);
    if (e != hipSuccess) fprintf(stderr, "cooperative launch failed: %s (grid %d)\n", hipGetErrorString(e), grid);
#else
    for (int p = 0; p < NPH; ++p) { a.ph_lo = p; a.ph_hi = p + 1; hipLaunchKernelGGL(mk_fwd, dim3(grid), dim3(512), LDS_BYTES, stream, a); }
#endif
}
```
